# Optimizing an MI355X kernel written in HIP

```python
import math
import jax
import jax.numpy as jnp
from jax import lax
import numpy as np

D_MODEL = 1024
BATCH = 2
SEQ = 16384
DEPTH = 2

GRID_W = 64
CTX_LEN = 256
HEAD_DIM = 64
MIX_WIDTH = D_MODEL
GROUP_WIDTH = MIX_WIDTH // 2
N_Q_HEADS = GROUP_WIDTH // HEAD_DIM
N_KV_HEADS = N_Q_HEADS // 4
KV_WIDTH = N_KV_HEADS * HEAD_DIM
HYENA_WIDTH = GROUP_WIDTH
HYENA_ORDER = 2
HYENA_SHORT_CONV = 3
HYENA_EMB = 33
HYENA_HIDDEN = 64
HYENA_DECAY_TARGET = 1e-2
HYENA_SHORT_DECAY_PCT = 0.3
HYENA_LONG_DECAY_PCT = 1.5
Q_BLOCK = 128
WINDOW = 128
NA_ROWS = 8
NA_COLS = 16
ROPE_THETA = 10000.0
EPS = 1e-6
NEG_INF = -1e30
N_EVEN = (DEPTH + 1) // 2
N_ODD = DEPTH // 2
EVEN_SPLITS = (GROUP_WIDTH, KV_WIDTH, KV_WIDTH, (HYENA_ORDER + 1) * HYENA_WIDTH, GROUP_WIDTH, HYENA_WIDTH)
ODD_SPLITS = (GROUP_WIDTH, KV_WIDTH, KV_WIDTH, GROUP_WIDTH, GROUP_WIDTH, GROUP_WIDTH, GROUP_WIDTH, GROUP_WIDTH)
IN_WIDTH = sum(EVEN_SPLITS)

kernel_name = "hybrid_flow_backbone"


def rms_norm(x, g):
    xf = x.astype(jnp.float32)
    y = xf * lax.rsqrt(jnp.mean(xf * xf, axis=-1, keepdims=True) + EPS)
    return (y * g.astype(jnp.float32)).astype(x.dtype)


def adaln(cond, w, b):
    m = jnp.matmul(jax.nn.silu(cond), w) + b
    return jnp.split(m, 3, axis=-1)


def modulated_norm(x, g, shift, scale):
    return rms_norm(x, g) * (1 + scale) + shift


def split_cols(p, sizes):
    idx = [int(v) for v in np.cumsum(sizes)[:-1]]
    return jnp.split(p, idx, axis=-1)


def heads(t, n):
    return t.reshape(t.shape[0], t.shape[1], n, HEAD_DIM)


def axial_rope_tables(n_tokens):
    t = jnp.arange(n_tokens, dtype=jnp.int32)
    row = (t // GRID_W).astype(jnp.float32)
    col = (t % GRID_W).astype(jnp.float32)
    n_pairs = HEAD_DIM // 4
    inv = ROPE_THETA ** (-jnp.arange(n_pairs, dtype=jnp.float32) / n_pairs)
    ang = jnp.concatenate([row[:, None] * inv, col[:, None] * inv], axis=-1)
    return jnp.cos(ang), jnp.sin(ang)


def apply_rope(x, cos, sin):
    b, n, h, dh = x.shape
    xf = x.astype(jnp.float32).reshape(b, n, h, dh // 2, 2)
    x0, x1 = xf[..., 0], xf[..., 1]
    cs, sn = cos[None, :, None, :], sin[None, :, None, :]
    out = jnp.stack([x0 * cs - x1 * sn, x0 * sn + x1 * cs], axis=-1)
    return out.reshape(b, n, h, dh).astype(x.dtype)


def context_attention(q_ctx, k_ctx, v_ctx, sink_logit=None):
    b, n, h, dh = q_ctx.shape
    kv = k_ctx.shape[2]
    g = h // kv
    qg = q_ctx.reshape(b, n, kv, g, dh)
    sc = jnp.einsum('bqkgd,bckd->bkgqc', qg, k_ctx).astype(jnp.float32) * dh ** -0.5
    if sink_logit is not None:
        sink = jnp.broadcast_to(sink_logit.astype(jnp.float32).reshape(1, kv, g, 1, 1), sc.shape[:-1] + (1,))
        p = jax.nn.softmax(jnp.concatenate([sc, sink], axis=-1), axis=-1)[..., :-1]
    else:
        p = jax.nn.softmax(sc, axis=-1)
    o = jnp.einsum('bkgqc,bckd->bqkgd', p.astype(v_ctx.dtype), v_ctx)
    return o.reshape(b, n, h * dh)


def global_gqa(q, k, v, k_ctx, v_ctx):
    b, s, h, dh = q.shape
    kv = k.shape[2]
    g = h // kv
    nb = s // Q_BLOCK
    k_all = jnp.concatenate([k_ctx, k], axis=1)
    v_all = jnp.concatenate([v_ctx, v], axis=1)
    scale = dh ** -0.5
    qb = q.reshape(b, nb, Q_BLOCK, kv, g, dh).swapaxes(0, 1)

    def one_block(q_blk):
        sc = jnp.einsum('bqkgd,bnkd->bkgqn', q_blk, k_all).astype(jnp.float32) * scale
        p = jax.nn.softmax(sc, axis=-1).astype(v_all.dtype)
        return jnp.einsum('bkgqn,bnkd->bqkgd', p, v_all)

    o = lax.map(one_block, qb)
    return o.swapaxes(0, 1).reshape(b, s, h * dh)


def windowed_gqa(q, k, v, k_ctx, v_ctx, sink_logit):
    b, s, h, dh = q.shape
    kv = k.shape[2]
    g = h // kv
    nb = s // Q_BLOCK
    side = WINDOW // Q_BLOCK
    span = (2 * side + 1) * Q_BLOCK
    n_ctx = k_ctx.shape[1]
    pad = ((0, 0), (side * Q_BLOCK, side * Q_BLOCK), (0, 0), (0, 0))
    kp = jnp.pad(k, pad).reshape(b, nb + 2 * side, Q_BLOCK, kv, dh)
    vp = jnp.pad(v, pad).reshape(b, nb + 2 * side, Q_BLOCK, kv, dh)
    kb = jnp.concatenate([kp[:, j:j + nb] for j in range(2 * side + 1)], axis=2)
    vb = jnp.concatenate([vp[:, j:j + nb] for j in range(2 * side + 1)], axis=2)
    qb = q.reshape(b, nb, Q_BLOCK, kv, g, dh)
    a = jnp.arange(Q_BLOCK)[:, None]
    j = jnp.arange(span)[None, :]
    band = jnp.abs(j - side * Q_BLOCK - a) <= WINDOW
    kpos = jnp.arange(nb)[:, None] * Q_BLOCK - side * Q_BLOCK + jnp.arange(span)[None, :]
    valid = band[None] & ((kpos >= 0) & (kpos < s))[:, None, :]
    sink = sink_logit.astype(jnp.float32).reshape(kv, g, 1, 1)
    scale = dh ** -0.5

    def one_block(args):
        q_blk, k_blk, v_blk, m = args
        s_loc = jnp.einsum('bqkgd,bjkd->bkgqj', q_blk, k_blk).astype(jnp.float32) * scale
        s_loc = jnp.where(m, s_loc, NEG_INF)
        s_ctx = jnp.einsum('bqkgd,bckd->bkgqc', q_blk, k_ctx).astype(jnp.float32) * scale
        s_sink = jnp.broadcast_to(sink, s_loc.shape[:-1] + (1,))
        p = jax.nn.softmax(jnp.concatenate([s_loc, s_ctx, s_sink], axis=-1), axis=-1)
        p_loc = p[..., :span].astype(v.dtype)
        p_ctx = p[..., span:span + n_ctx].astype(v.dtype)
        return (jnp.einsum('bkgqj,bjkd->bqkgd', p_loc, v_blk)
                + jnp.einsum('bkgqc,bckd->bqkgd', p_ctx, v_ctx))

    xs = (qb.swapaxes(0, 1), kb.swapaxes(0, 1), vb.swapaxes(0, 1), valid)
    o = lax.map(one_block, xs)
    return o.swapaxes(0, 1).reshape(b, s, h * dh)


def neighbourhood_attention(q, k, v, k_ctx, v_ctx, rpb):
    b, s, h, dh = q.shape
    rows = s // GRID_W
    kr = min(NA_ROWS, rows)
    kw = min(NA_COLS, GRID_W)
    nk = kr * kw
    t = jnp.arange(s, dtype=jnp.int32)
    r = t // GRID_W
    col = t % GRID_W
    r0 = jnp.clip(r - kr // 2, 0, rows - kr)
    c0 = jnp.clip(col - kw // 2, 0, GRID_W - kw)
    key_r = r0[:, None, None] + jnp.arange(kr, dtype=jnp.int32)[None, :, None]
    key_c = c0[:, None, None] + jnp.arange(kw, dtype=jnp.int32)[None, None, :]
    key_idx = (key_r * GRID_W + key_c).reshape(s, nk)
    rel_idx = ((key_r - r[:, None, None] + NA_ROWS - 1) * (2 * NA_COLS - 1)
               + (key_c - col[:, None, None] + NA_COLS - 1)).reshape(s, nk)
    nb = s // Q_BLOCK
    rpb_flat = rpb.reshape(h, -1).astype(jnp.float32)
    scale = dh ** -0.5
    n_ctx = k_ctx.shape[1]

    def one_block(args):
        q_blk, idx, ridx = args
        kg = jnp.take(k, idx.reshape(-1), axis=1).reshape(b, Q_BLOCK, nk, h, dh)
        vg = jnp.take(v, idx.reshape(-1), axis=1).reshape(b, Q_BLOCK, nk, h, dh)
        s_loc = (jnp.einsum('bqhd,bqnhd->bhqn', q_blk, kg).astype(jnp.float32) * scale
                 + jnp.take(rpb_flat, ridx, axis=1)[None])
        s_ctx = jnp.einsum('bqhd,bchd->bhqc', q_blk, k_ctx).astype(jnp.float32) * scale
        p = jax.nn.softmax(jnp.concatenate([s_loc, s_ctx], axis=-1), axis=-1)
        p_loc = p[..., :nk].astype(v.dtype)
        p_ctx = p[..., nk:nk + n_ctx].astype(v.dtype)
        return (jnp.einsum('bhqn,bqnhd->bqhd', p_loc, vg)
                + jnp.einsum('bhqc,bchd->bqhd', p_ctx, v_ctx))

    xs = (q.reshape(b, nb, Q_BLOCK, h, dh).swapaxes(0, 1),
          key_idx.reshape(nb, Q_BLOCK, nk), rel_idx.reshape(nb, Q_BLOCK, nk))
    o = lax.map(one_block, xs)
    return o.swapaxes(0, 1).reshape(b, s, h * dh)


def hyena_positional_features(n):
    t = jnp.linspace(0.0, 1.0, n, dtype=jnp.float32)[:, None]
    bands = (HYENA_EMB - 1) // 2
    w = 2.0 * math.pi * jnp.arange(n, dtype=jnp.float32)[:, None] / n
    f = jnp.linspace(1e-4, bands - 1, bands, dtype=jnp.float32)[None, :]
    return jnp.concatenate([t, jnp.cos(f * w), -jnp.sin(f * w)], axis=-1)


def hyena_filters(n, w1, b1, w2, b2, freq, w3):
    f32 = jnp.float32
    z = hyena_positional_features(n)
    fr = freq.astype(f32)
    hdn = jnp.sin(fr * (z @ w1.astype(f32) + b1.astype(f32)))
    hdn = jnp.sin(fr * (hdn @ w2.astype(f32) + b2.astype(f32)))
    filt = hdn @ w3.astype(f32)
    t = jnp.linspace(0.0, 1.0, n, dtype=f32)[:, None]
    deltas = jnp.linspace(math.log(HYENA_DECAY_TARGET) / HYENA_LONG_DECAY_PCT,
                          math.log(HYENA_DECAY_TARGET) / HYENA_SHORT_DECAY_PCT, HYENA_WIDTH, dtype=f32)
    decay = jnp.exp(-t * jnp.abs(deltas))
    return filt.reshape(n, HYENA_ORDER, 2, HYENA_WIDTH) * decay[:, None, None, :]


def bidir_long_conv(z, h_fwd, h_bwd, d_skip):
    n = z.shape[1]
    taps = jnp.concatenate([h_fwd, jnp.zeros_like(h_fwd[:1]), h_bwd[:0:-1]], axis=0)
    taps = taps * lax.rsqrt(jnp.sum(taps * taps, axis=0, keepdims=True) + EPS)
    zf = jnp.fft.rfft(z.astype(jnp.float32), n=2 * n, axis=1)
    tf = jnp.fft.rfft(taps, n=2 * n, axis=0)
    y = jnp.fft.irfft(zf * tf[None], n=2 * n, axis=1)[:, :n]
    return (y + z.astype(jnp.float32) * d_skip.astype(jnp.float32)).astype(z.dtype)


def centred_depthwise_conv(u, w, bias):
    pad = w.shape[0] // 2
    y = lax.conv_general_dilated(u, w[:, None, :].astype(u.dtype), window_strides=(1,),
                                 padding=[(pad, pad)], dimension_numbers=('NWC', 'WIO', 'NWC'),
                                 feature_group_count=u.shape[-1])
    return y + bias


def hyena_branch(u, conv_w, conv_b, w1, b1, w2, b2, freq, w3, d_skip):
    n = u.shape[1]
    filt = hyena_filters(n, w1, b1, w2, b2, freq, w3)
    uc = centred_depthwise_conv(u, conv_w, conv_b)
    parts = jnp.split(uc, HYENA_ORDER + 1, axis=-1)
    z = parts[0]
    for o in range(HYENA_ORDER):
        z = parts[o + 1] * bidir_long_conv(z, filt[:, o, 0], filt[:, o, 1], d_skip[o])
    return z


def even_mixer(p, p_ctx, q_norm, k_norm, conv_w, conv_b, w1, b1, w2, b2, freq, w3, d_skip, cos, sin, need_ctx):
    aq, ak, av, hu, ag, hg = split_cols(p, EVEN_SPLITS)
    caq, cak, cav, chu, cag, chg = split_cols(p_ctx, EVEN_SPLITS)
    q = apply_rope(rms_norm(heads(aq, N_Q_HEADS), q_norm), cos, sin)
    k = apply_rope(rms_norm(heads(ak, N_KV_HEADS), k_norm), cos, sin)
    v = heads(av, N_KV_HEADS)
    k_c = rms_norm(heads(cak, N_KV_HEADS), k_norm)
    v_c = heads(cav, N_KV_HEADS)
    y_a = global_gqa(q, k, v, k_c, v_c)
    y_b = hyena_branch(hu, conv_w, conv_b, w1, b1, w2, b2, freq, w3, d_skip)
    y = jnp.concatenate([y_a * jax.nn.silu(ag), y_b * jax.nn.silu(hg)], axis=-1)
    if not need_ctx:
        return y, None
    q_c = rms_norm(heads(caq, N_Q_HEADS), q_norm)
    y_ca = context_attention(q_c, k_c, v_c)
    y_cb = hyena_branch(chu, conv_w, conv_b, w1, b1, w2, b2, freq, w3, d_skip)
    y_c = jnp.concatenate([y_ca * jax.nn.silu(cag), y_cb * jax.nn.silu(chg)], axis=-1)
    return y, y_c


def odd_mixer(p, p_ctx, wq_norm, wk_norm, sink, nq_norm, nk_norm, rpb, cos, sin, need_ctx):
    wq, wk, wv, nq, nk_, nv, wg, ng = split_cols(p, ODD_SPLITS)
    cwq, cwk, cwv, cnq, cnk, cnv, cwg, cng = split_cols(p_ctx, ODD_SPLITS)
    q_w = apply_rope(rms_norm(heads(wq, N_Q_HEADS), wq_norm), cos, sin)
    k_w = apply_rope(rms_norm(heads(wk, N_KV_HEADS), wk_norm), cos, sin)
    v_w = heads(wv, N_KV_HEADS)
    kc_w = rms_norm(heads(cwk, N_KV_HEADS), wk_norm)
    vc_w = heads(cwv, N_KV_HEADS)
    y_w = windowed_gqa(q_w, k_w, v_w, kc_w, vc_w, sink)
    q_n = rms_norm(heads(nq, N_Q_HEADS), nq_norm)
    k_n = rms_norm(heads(nk_, N_Q_HEADS), nk_norm)
    v_n = heads(nv, N_Q_HEADS)
    kc_n = rms_norm(heads(cnk, N_Q_HEADS), nk_norm)
    vc_n = heads(cnv, N_Q_HEADS)
    y_n = neighbourhood_attention(q_n, k_n, v_n, kc_n, vc_n, rpb)
    y = jnp.concatenate([y_w * jax.nn.silu(wg), y_n * jax.nn.silu(ng)], axis=-1)
    if not need_ctx:
        return y, None
    y_cw = context_attention(rms_norm(heads(cwq, N_Q_HEADS), wq_norm), kc_w, vc_w, sink)
    y_cn = context_attention(rms_norm(heads(cnq, N_Q_HEADS), nq_norm), kc_n, vc_n)
    y_c = jnp.concatenate([y_cw * jax.nn.silu(cwg), y_cn * jax.nn.silu(cng)], axis=-1)
    return y, y_c


def setup_inputs(seed: int = 0) -> dict:
    key = jax.random.key(seed)
    keys = iter(jax.random.split(key, 32))

    def nrm(shape, std):
        return std * jax.random.normal(next(keys), shape, jnp.float32)

    n_filter_out = HYENA_ORDER * 2 * HYENA_WIDTH
    n_hy_in = (HYENA_ORDER + 1) * HYENA_WIDTH
    return {
        'x': nrm((BATCH, SEQ, D_MODEL), 1.0),
        'c': nrm((BATCH, D_MODEL), 1.0),
        'ctx': nrm((BATCH, CTX_LEN, D_MODEL), 1.0),
        'c_ctx': nrm((D_MODEL,), 1.0),
        'norm_g': 1.0 + nrm((DEPTH, D_MODEL), 0.1),
        'w_ada': nrm((DEPTH, D_MODEL, 3 * D_MODEL), D_MODEL ** -0.5),
        'b_ada': nrm((DEPTH, 3 * D_MODEL), 0.01),
        'w_in': nrm((DEPTH, D_MODEL, IN_WIDTH), D_MODEL ** -0.5),
        'w_out': nrm((DEPTH, MIX_WIDTH, D_MODEL), MIX_WIDTH ** -0.5),
        'glob_q_norm': 1.0 + nrm((N_EVEN, HEAD_DIM), 0.1),
        'glob_k_norm': 1.0 + nrm((N_EVEN, HEAD_DIM), 0.1),
        'hy_conv_w': nrm((N_EVEN, HYENA_SHORT_CONV, n_hy_in), HYENA_SHORT_CONV ** -0.5),
        'hy_conv_b': nrm((N_EVEN, n_hy_in), 0.01),
        'hy_w1': nrm((N_EVEN, HYENA_EMB, HYENA_HIDDEN), HYENA_EMB ** -0.5),
        'hy_b1': nrm((N_EVEN, HYENA_HIDDEN), 0.01),
        'hy_w2': nrm((N_EVEN, HYENA_HIDDEN, HYENA_HIDDEN), HYENA_HIDDEN ** -0.5),
        'hy_b2': nrm((N_EVEN, HYENA_HIDDEN), 0.01),
        'hy_freq': 1.0 + nrm((N_EVEN, HYENA_HIDDEN), 0.1),
        'hy_w3': nrm((N_EVEN, HYENA_HIDDEN, n_filter_out), HYENA_HIDDEN ** -0.5),
        'hy_skip': nrm((N_EVEN, HYENA_ORDER, HYENA_WIDTH), 0.5),
        'win_q_norm': 1.0 + nrm((N_ODD, HEAD_DIM), 0.1),
        'win_k_norm': 1.0 + nrm((N_ODD, HEAD_DIM), 0.1),
        'win_sink': nrm((N_ODD, N_Q_HEADS), 0.5),
        'nat_q_norm': 1.0 + nrm((N_ODD, HEAD_DIM), 0.1),
        'nat_k_norm': 1.0 + nrm((N_ODD, HEAD_DIM), 0.1),
        'nat_rpb': nrm((N_ODD, N_Q_HEADS, 2 * NA_ROWS - 1, 2 * NA_COLS - 1), 0.1),
    }


def reference(x, c, ctx, c_ctx, norm_g, w_ada, b_ada, w_in, w_out,
              glob_q_norm, glob_k_norm, hy_conv_w, hy_conv_b, hy_w1, hy_b1, hy_w2, hy_b2,
              hy_freq, hy_w3, hy_skip, win_q_norm, win_k_norm, win_sink,
              nat_q_norm, nat_k_norm, nat_rpb):
    cos, sin = axial_rope_tables(x.shape[1])
    x_ctx = ctx
    for layer in range(DEPTH):
        need_ctx = layer < DEPTH - 1
        shift, scale, gate = adaln(c, w_ada[layer], b_ada[layer])
        c_shift, c_scale, c_gate = adaln(c_ctx, w_ada[layer], b_ada[layer])
        h = modulated_norm(x, norm_g[layer], shift[:, None], scale[:, None])
        h_ctx = modulated_norm(x_ctx, norm_g[layer], c_shift, c_scale)
        p = jnp.matmul(h, w_in[layer])
        p_ctx = jnp.matmul(h_ctx, w_in[layer])
        i = layer // 2
        if layer % 2 == 0:
            y, y_ctx = even_mixer(p, p_ctx, glob_q_norm[i], glob_k_norm[i], hy_conv_w[i], hy_conv_b[i],
                                  hy_w1[i], hy_b1[i], hy_w2[i], hy_b2[i], hy_freq[i], hy_w3[i], hy_skip[i],
                                  cos, sin, need_ctx)
        else:
            y, y_ctx = odd_mixer(p, p_ctx, win_q_norm[i], win_k_norm[i], win_sink[i],
                                 nat_q_norm[i], nat_k_norm[i], nat_rpb[i], cos, sin, need_ctx)
        x = x + gate[:, None] * jnp.matmul(y, w_out[layer])
        if need_ctx:
            x_ctx = x_ctx + c_gate * jnp.matmul(y_ctx, w_out[layer])
    return x
```

```cpp
#include <hip/hip_runtime.h>
#include <hip/hip_cooperative_groups.h>
#include <cstdio>
#include <cstdint>
namespace cg = cooperative_groups;

typedef unsigned short u16;
using bf16x8 = __attribute__((ext_vector_type(8))) short;
using f32x16 = __attribute__((ext_vector_type(16))) float;
typedef __bf16 bf16x2_t __attribute__((ext_vector_type(2)));
#define DI __device__ __forceinline__
#define MFMA(a, b, c) __builtin_amdgcn_mfma_f32_32x32x16_bf16((a), (b), (c), 0, 0, 0)

constexpr int S = 16384, DM = 1024, NB = 2, NC = 256, INW = 3328;
constexpr int KTOT = S + NC;
constexpr int MLAT = NB * S;
constexpr int MALL = MLAT + NB * NC;
constexpr int NTHR = 512;
constexpr float LOG2E = 1.4426950408889634f;
constexpr float QSCALE = 0.125f * LOG2E;
constexpr float EPSF = 1e-6f;
constexpr size_t MiB = 1024 * 1024;
constexpr size_t OFF_MOD = 0;
constexpr size_t OFF_ROPE = 128 * 1024;
constexpr size_t OFF_BAR = 512 * 1024;
constexpr size_t OFF_WINT = 1 * MiB;
constexpr size_t OFF_WOUTT = 15 * MiB;
constexpr size_t OFF_HDN2 = 19 * MiB;
constexpr size_t OFF_HDN2C = 23 * MiB;
constexpr size_t OFF_XC1 = 24 * MiB;
constexpr size_t OFF_FILTTC = 26 * MiB;
constexpr size_t OFF_QC = 28 * MiB;
constexpr size_t OFF_UTC = 29 * MiB;
constexpr size_t OFF_HGTC = 32 * MiB;
constexpr size_t OFF_H = 34 * MiB;
constexpr size_t OFF_Y = 99 * MiB;
constexpr size_t OFF_FILTT = 164 * MiB;
constexpr size_t OFF_Q = 292 * MiB;
constexpr size_t OFF_K = 324 * MiB;
constexpr size_t OFF_VT = 333 * MiB;
constexpr size_t OFF_UT = 342 * MiB;
constexpr size_t OFF_HGT = 438 * MiB;
constexpr size_t WS_NEED = 470 * MiB;
constexpr size_t OFF_QW = 164 * MiB;
constexpr size_t OFF_KW = 196 * MiB;
constexpr size_t OFF_VWT = 205 * MiB;
constexpr size_t OFF_QN = 214 * MiB;
constexpr size_t OFF_KN = 246 * MiB;
constexpr size_t OFF_VNT = 279 * MiB;
constexpr int LDS_BYTES = 147456 + 16;

#ifndef ONLY_PHASE
#define ONLY_PHASE -1
#endif
#define PH(k) (ONLY_PHASE < 0 || ONLY_PHASE == (k))
struct Params {
  const float *x, *c, *ctx, *c_ctx, *norm_g, *w_ada, *b_ada, *w_in, *w_out;
  const float *gq, *gk, *cw, *cb, *w1, *b1, *w2, *b2, *fr, *w3, *skip;
  const float *wqn, *wkn, *sink, *nqn, *nkn, *rpb;
  float* out;
  unsigned char* ws;
  int phase_lo, phase_hi;
};

DI unsigned pack2(float a, float b) { bf16x2_t v = {(__bf16)a, (__bf16)b}; return __builtin_bit_cast(unsigned, v); }
DI unsigned pack2a(float a, float b) { unsigned r; asm("v_cvt_pk_bf16_f32 %0, %1, %2" : "=v"(r) : "v"(a), "v"(b)); return r; }
DI u16 f2bf(float a) { return __builtin_bit_cast(u16, (__bf16)a); }
DI float bf2f(u16 v) { return __uint_as_float(((unsigned)v) << 16); }
DI float siluf(float v) { return v / (1.f + __expf(-v)); }
DI int crow(int reg, int h) { return (reg & 3) + 8 * (reg >> 2) + 4 * h; }
DI float wave_sum(float v) {
#pragma unroll
  for (int o = 32; o >= 1; o >>= 1) v += __shfl_xor(v, o);
  return v;
}
DI float block_sum(float v, float* red) {
  v = wave_sum(v);
  __syncthreads();
  if ((threadIdx.x & 63) == 0) red[threadIdx.x >> 6] = v;
  __syncthreads();
  float s = 0.f;
#pragma unroll
  for (int i = 0; i < 8; ++i) s += red[i];
  return s;
}

DI void p0_transpose(const float* W, int K, int N, u16* WT, int k0, int n0, float* tile) {
  const int t = threadIdx.x;
  __syncthreads();
#pragma unroll
  for (int i = 0; i < 8; ++i) { int e = t + 512 * i; int kk = e >> 6, nn = e & 63; tile[kk * 65 + nn] = W[(size_t)(k0 + kk) * N + n0 + nn]; }
  __syncthreads();
#pragma unroll
  for (int i = 0; i < 8; ++i) { int e = t + 512 * i; int nn = e >> 6, kk = e & 63; WT[(size_t)(n0 + nn) * K + k0 + kk] = f2bf(tile[kk * 65 + nn]); }
}

DI void p0_adaln(const Params& p, int l, int nc, float* sm) {
  const int t = threadIdx.x;
  float* mod = (float*)(p.ws + OFF_MOD);
  __syncthreads();
  for (int e = t; e < 3072; e += 512) { int v = e >> 10, k = e & 1023; float cv = v < 2 ? p.c[v * 1024 + k] : p.c_ctx[k]; sm[e] = cv / (1.f + expf(-cv)); }
  __syncthreads();
  const int n = t & 63, kg = t >> 6;
  const float* W = p.w_ada + (size_t)l * 1024 * 3072 + nc * 64 + n;
  float a0 = 0.f, a1 = 0.f, a2 = 0.f;
  for (int k = kg * 128; k < kg * 128 + 128; ++k) { float w = W[(size_t)k * 3072]; a0 += sm[k] * w; a1 += sm[1024 + k] * w; a2 += sm[2048 + k] * w; }
  float* red = sm + 3072;
  red[(kg * 3 + 0) * 64 + n] = a0; red[(kg * 3 + 1) * 64 + n] = a1; red[(kg * 3 + 2) * 64 + n] = a2;
  __syncthreads();
  if (t < 192) {
    int v = t >> 6; float s = 0.f;
    for (int g = 0; g < 8; ++g) s += red[(g * 3 + v) * 64 + n];
    mod[(l * 3 + v) * 3072 + nc * 64 + n] = s + p.b_ada[l * 3072 + nc * 64 + n];
  }
}

DI void p0_mlp(const Params& p, int tbase, int n, float* dst, float* sm) {
  const int t = threadIdx.x, tl = t >> 6, j = t & 63;
  float* zs = sm;
  float* hs = sm + 8 * 36;
  float* w1s = sm + 1024;
  float* w2s = w1s + 33 * 64;
  __syncthreads();
  for (int e = t; e < 33 * 64; e += 512) w1s[e] = p.w1[e];
  for (int e = t; e < 64 * 64; e += 512) w2s[e] = p.w2[e];
  const float frj = p.fr[j], b1j = p.b1[j], b2j = p.b2[j];
#pragma nounroll
  for (int g = 0; g < 8; ++g) {
    const int tt = tbase + g * 8 + tl;
    __syncthreads();
    if (j < 33) {
      float val;
      if (j == 0) val = (float)tt / (float)(n - 1);
      else {
        const float w = (6.283185307179586f * (float)tt) / (float)n;
        const int i = (j - 1) & 15;
        const float f = 1e-4f + (float)i * ((15.0f - 1e-4f) / 15.0f);
        val = (j <= 16) ? cosf(f * w) : -sinf(f * w);
      }
      zs[tl * 36 + j] = val;
    }
    __syncthreads();
    float a = b1j;
#pragma unroll
    for (int i = 0; i < 33; ++i) a += zs[tl * 36 + i] * w1s[i * 64 + j];
    hs[tl * 64 + j] = sinf(frj * a);
    __syncthreads();
    float a2 = b2j;
#pragma unroll
    for (int i = 0; i < 64; ++i) a2 += hs[tl * 64 + i] * w2s[i * 64 + j];
    dst[(size_t)tt * 64 + j] = sinf(frj * a2);
  }
}

DI void phase0(const Params& p, unsigned char* smem) {
  float* sm = (float*)smem;
  for (int it = blockIdx.x; it < 2533; it += gridDim.x) {
    if (it < 1664) {
      int l = it / 832, rem = it % 832; int kt = rem / 52, nt = rem % 52;
      p0_transpose(p.w_in + (size_t)l * 1024 * INW, 1024, INW, (u16*)(p.ws + OFF_WINT) + (size_t)l * INW * 1024, kt * 64, nt * 64, sm);
    } else if (it < 2176) {
      int i2 = it - 1664; int l = i2 >> 8, rem = i2 & 255; int kt = rem >> 4, nt = rem & 15;
      p0_transpose(p.w_out + (size_t)l * 1024 * 1024, 1024, 1024, (u16*)(p.ws + OFF_WOUTT) + (size_t)l * 1024 * 1024, kt * 64, nt * 64, sm);
    } else if (it < 2272) {
      int i2 = it - 2176; p0_adaln(p, i2 / 48, i2 % 48, sm);
    } else if (it < 2528) {
      p0_mlp(p, (it - 2272) * 64, S, (float*)(p.ws + OFF_HDN2), sm);
    } else if (it < 2532) {
      p0_mlp(p, (it - 2528) * 64, NC, (float*)(p.ws + OFF_HDN2C), sm);
    } else {
      float2* tab = (float2*)(p.ws + OFF_ROPE);
      for (int e = threadIdx.x; e < 5120; e += 512) {
        int pos = e >> 4, pi = e & 15; float pv = (float)(pos < 256 ? pos : pos - 256);
        float inv = powf(10000.0f, -(float)pi / 16.0f);
        float ang = pv * inv; float sn, cs; sincosf(ang, &sn, &cs);
        tab[e] = make_float2(cs, sn);
      }
    }
  }
}

DI void modnorm_rows(const Params& p, int layer, int item) {
  const int w = threadIdx.x >> 6, lane = threadIdx.x & 63;
  const float* g = p.norm_g + layer * 1024;
  const float* src[2]; const float* md[2]; int rowi[2];
#pragma unroll
  for (int j = 0; j < 2; ++j) {
    const int row = item * 16 + j * 8 + w; int v;
    if (row < MLAT) { src[j] = (layer == 0 ? p.x : (const float*)p.out) + (size_t)row * 1024; v = row >> 14; }
    else { src[j] = (layer == 0 ? p.ctx : (const float*)(p.ws + OFF_XC1)) + (size_t)(row - MLAT) * 1024; v = 2; }
    md[j] = (const float*)(p.ws + OFF_MOD) + (layer * 3 + v) * 3072; rowi[j] = row;
  }
  float4 xv[2][4]; float ss[2] = {0.f, 0.f};
#pragma unroll
  for (int j = 0; j < 2; ++j)
#pragma unroll
    for (int i = 0; i < 4; ++i) xv[j][i] = *(const float4*)(src[j] + i * 256 + lane * 4);
#pragma unroll
  for (int j = 0; j < 2; ++j) {
#pragma unroll
    for (int i = 0; i < 4; ++i) ss[j] += xv[j][i].x * xv[j][i].x + xv[j][i].y * xv[j][i].y + xv[j][i].z * xv[j][i].z + xv[j][i].w * xv[j][i].w;
    ss[j] = wave_sum(ss[j]);
  }
#pragma unroll
  for (int j = 0; j < 2; ++j) {
    const float rstd = rsqrtf(ss[j] * (1.f / 1024.f) + EPSF);
    u16* h = (u16*)(p.ws + OFF_H) + (size_t)rowi[j] * 1024;
#pragma unroll
    for (int i = 0; i < 4; ++i) {
      const int col = i * 256 + lane * 4;
      const float4 g4 = *(const float4*)(g + col), sh = *(const float4*)(md[j] + col), sc = *(const float4*)(md[j] + 1024 + col);
      float y0 = xv[j][i].x * rstd * g4.x * (1.f + sc.x) + sh.x, y1 = xv[j][i].y * rstd * g4.y * (1.f + sc.y) + sh.y;
      float y2 = xv[j][i].z * rstd * g4.z * (1.f + sc.z) + sh.z, y3 = xv[j][i].w * rstd * g4.w * (1.f + sc.w) + sh.w;
      *(uint2*)(h + col) = make_uint2(pack2(y0, y1), pack2(y2, y3));
    }
  }
}

DI void filt_item(const Params& p, int tb, int cg) {
  const int t = threadIdx.x, lane = t & 63, w = t >> 6, r = lane & 31, h = lane >> 5;
  const bool isctx = (tb == 64);
  const int n = isctx ? NC : S;
  const float* hd = isctx ? (const float*)(p.ws + OFF_HDN2C) : (const float*)(p.ws + OFF_HDN2);
  float* dst = isctx ? (float*)(p.ws + OFF_FILTTC) : (float*)(p.ws + OFF_FILTT);
  const int t0 = (isctx ? 0 : tb * 256) + w * 32;
  float bv[32];
  const float* hr = hd + (size_t)(t0 + r) * 64 + h * 32;
#pragma unroll
  for (int i = 0; i < 8; ++i) { float4 q4 = *(const float4*)(hr + i * 4); bv[4 * i] = q4.x; bv[4 * i + 1] = q4.y; bv[4 * i + 2] = q4.z; bv[4 * i + 3] = q4.w; }
  const float tl2 = -((float)(t0 + r) / (float)(n - 1)) * LOG2E;
  const float da = -3.0701134573253945f, db = -15.350567286626972f;
#pragma nounroll
  for (int ct = 0; ct < 16; ++ct) {
    const int col0 = cg * 512 + ct * 32;
    const float* wp = p.w3 + (size_t)(h * 32) * 2048 + col0 + r;
    f32x16 acc;
#pragma unroll
    for (int i = 0; i < 16; ++i) acc[i] = 0.f;
#pragma unroll
    for (int s = 0; s < 32; ++s) acc = __builtin_amdgcn_mfma_f32_32x32x2f32(wp[(size_t)s * 2048], bv[s], acc, 0, 0, 0);
#pragma unroll
    for (int reg = 0; reg < 16; ++reg) {
      const int col = col0 + crow(reg, h); const int ch = col & 511;
      const float delta = da + (db - da) * ((float)ch / 511.0f);
      const float dec = __builtin_amdgcn_exp2f(tl2 * fabsf(delta));
      if (isctx) dst[(size_t)col * n + t0 + r] = acc[reg] * dec;
      else ((u16*)dst)[(size_t)col * n + t0 + r] = f2bf(acc[reg] * dec);
    }
  }
}

DI void phase1(const Params& p, unsigned char* smem) {
  for (int it = blockIdx.x; it < 256; it += gridDim.x) filt_item(p, it >> 2, it & 3);
  for (int it = blockIdx.x; it < 2080 + 4; it += gridDim.x) {
    if (it < 2080) modnorm_rows(p, 0, it); else filt_item(p, 64, it - 2080);
  }
}

DI float head_rstd(const f32x16& a0, const f32x16& a1) {
  float ss = 0.f;
#pragma unroll
  for (int i = 0; i < 16; ++i) ss += a0[i] * a0[i] + a1[i] * a1[i];
  ss += __shfl_xor(ss, 32);
  return rsqrtf(ss * (1.f / 64.f) + EPSF);
}
DI void store_qk(const f32x16& a0, const f32x16& a1, const float* gn, bool rope, int tpos, float scale, u16* dst, const float2* tab, int h) {
  const float rstd = head_rstd(a0, a1) ;
#pragma unroll
  for (int ni = 0; ni < 2; ++ni) {
#pragma unroll
    for (int q = 0; q < 4; ++q) {
      const int f0 = ni * 32 + 8 * q + 4 * h;
      const float4 g4 = *(const float4*)(gn + f0);
      float v0 = (ni == 0 ? a0[4 * q] : a1[4 * q]) * rstd * g4.x;
      float v1 = (ni == 0 ? a0[4 * q + 1] : a1[4 * q + 1]) * rstd * g4.y;
      float v2 = (ni == 0 ? a0[4 * q + 2] : a1[4 * q + 2]) * rstd * g4.z;
      float v3 = (ni == 0 ? a0[4 * q + 3] : a1[4 * q + 3]) * rstd * g4.w;
      if (rope) {
        const int pa = 4 * q + 2 * h;
        const float2* tr = (ni == 0) ? (tab + (tpos >> 6) * 16) : (tab + (256 + (tpos & 63)) * 16);
        const float2 ca = tr[pa], cb = tr[pa + 1];
        float r0 = v0 * ca.x - v1 * ca.y, r1 = v0 * ca.y + v1 * ca.x;
        float r2 = v2 * cb.x - v3 * cb.y, r3 = v2 * cb.y + v3 * cb.x;
        v0 = r0; v1 = r1; v2 = r2; v3 = r3;
      }
      *(uint2*)(dst + f0) = make_uint2(pack2(v0 * scale, v1 * scale), pack2(v2 * scale, v3 * scale));
    }
  }
}
DI void store_T_bf16(const f32x16& a0, const f32x16& a1, u16* dst, size_t pitch, int h, bool dosilu) {
#pragma unroll
  for (int ni = 0; ni < 2; ++ni)
#pragma unroll
    for (int reg = 0; reg < 16; ++reg) {
      float v = ni == 0 ? a0[reg] : a1[reg];
      if (dosilu) v = siluf(v);
      dst[(size_t)(ni * 32 + crow(reg, h)) * pitch] = f2bf(v);
    }
}
DI void store_T_f32(const f32x16& a0, const f32x16& a1, float* dst, size_t pitch, int h, bool dosilu) {
#pragma unroll
  for (int ni = 0; ni < 2; ++ni)
#pragma unroll
    for (int reg = 0; reg < 16; ++reg) {
      float v = ni == 0 ? a0[reg] : a1[reg];
      if (dosilu) v = siluf(v);
      dst[(size_t)(ni * 32 + crow(reg, h)) * pitch] = v;
    }
}
DI void store_silu_row(const f32x16& a0, const f32x16& a1, u16* dst, int h) {
#pragma unroll
  for (int ni = 0; ni < 2; ++ni)
#pragma unroll
    for (int q = 0; q < 4; ++q) {
      const int f0 = ni * 32 + 8 * q + 4 * h;
      float v0 = siluf(ni == 0 ? a0[4 * q] : a1[4 * q]), v1 = siluf(ni == 0 ? a0[4 * q + 1] : a1[4 * q + 1]);
      float v2 = siluf(ni == 0 ? a0[4 * q + 2] : a1[4 * q + 2]), v3 = siluf(ni == 0 ? a0[4 * q + 3] : a1[4 * q + 3]);
      *(uint2*)(dst + f0) = make_uint2(pack2(v0, v1), pack2(v2, v3));
    }
}

template <int EPI>
DI void gemm_epilogue(const Params& p, f32x16 (&acc)[2][4], int nb, int mb, int r, int h) {
  unsigned char* ws = p.ws;
  const float2* tab = (const float2*)(ws + OFF_ROPE);
  const bool isctx = mb >= MLAT;
#pragma unroll
  for (int mi = 0; mi < 4; ++mi) {
    const int mrow = mb + mi * 32 + r;
    const int b = isctx ? ((mrow - MLAT) >> 8) : (mrow >> 14);
    const int tpos = isctx ? ((mrow - MLAT) & 255) : (mrow & (S - 1));
    const int kpos = isctx ? tpos : NC + tpos;
    const f32x16& a0 = acc[0][mi];
    const f32x16& a1 = acc[1][mi];
    if (EPI == 0) {
      if (nb < 512) {
        const int head = nb >> 6;
        u16* dst = isctx ? (u16*)(ws + OFF_QC) + ((size_t)(b * 8 + head) * NC + tpos) * 64 : (u16*)(ws + OFF_Q) + ((size_t)(b * 8 + head) * S + tpos) * 64;
        store_qk(a0, a1, p.gq, !isctx, tpos, QSCALE, dst, tab, h);
      } else if (nb < 640) {
        const int kvh = (nb - 512) >> 6;
        store_qk(a0, a1, p.gk, !isctx, tpos, 1.f, (u16*)(ws + OFF_K) + ((size_t)(b * 2 + kvh) * KTOT + kpos) * 64, tab, h);
      } else if (nb < 768) {
        const int kvh = (nb - 640) >> 6;
        store_T_bf16(a0, a1, (u16*)(ws + OFF_VT) + (size_t)(b * 2 + kvh) * 64 * KTOT + kpos, KTOT, h, false);
      } else if (nb < 2304) {
        const int ch = nb - 768;
        if (isctx) store_T_f32(a0, a1, (float*)(ws + OFF_UTC) + (size_t)(b * 1536 + ch) * NC + tpos, NC, h, false);
        else store_T_bf16(a0, a1, (u16*)(ws + OFF_UT) + (size_t)(b * 1536 + ch) * S + tpos, S, h, false);
      } else if (nb < 2816) {
        store_silu_row(a0, a1, (u16*)(ws + OFF_Y) + (size_t)mrow * 1024 + (nb - 2304), h);
      } else {
        const int ch = nb - 2816;
        if (isctx) store_T_f32(a0, a1, (float*)(ws + OFF_HGTC) + (size_t)(b * 512 + ch) * NC + tpos, NC, h, true);
        else store_T_bf16(a0, a1, (u16*)(ws + OFF_HGT) + (size_t)(b * 512 + ch) * S + tpos, S, h, true);
      }
    } else if (EPI == 1) {
      if (nb < 512) {
        if (!isctx) store_qk(a0, a1, p.wqn, true, tpos, QSCALE, (u16*)(ws + OFF_QW) + ((size_t)(b * 8 + (nb >> 6)) * S + tpos) * 64, tab, h);
      } else if (nb < 640) {
        const int kvh = (nb - 512) >> 6;
        store_qk(a0, a1, p.wkn, !isctx, tpos, 1.f, (u16*)(ws + OFF_KW) + ((size_t)(b * 2 + kvh) * KTOT + kpos) * 64, tab, h);
      } else if (nb < 768) {
        const int kvh = (nb - 640) >> 6;
        store_T_bf16(a0, a1, (u16*)(ws + OFF_VWT) + (size_t)(b * 2 + kvh) * 64 * KTOT + kpos, KTOT, h, false);
      } else if (nb < 1280) {
        if (!isctx) store_qk(a0, a1, p.nqn, false, tpos, QSCALE, (u16*)(ws + OFF_QN) + ((size_t)(b * 8 + ((nb - 768) >> 6)) * S + tpos) * 64, tab, h);
      } else if (nb < 1792) {
        const int head = (nb - 1280) >> 6;
        store_qk(a0, a1, p.nkn, false, tpos, 1.f, (u16*)(ws + OFF_KN) + ((size_t)(b * 8 + head) * KTOT + kpos) * 64, tab, h);
      } else if (nb < 2304) {
        const int head = (nb - 1792) >> 6;
        store_T_bf16(a0, a1, (u16*)(ws + OFF_VNT) + (size_t)(b * 8 + head) * 64 * KTOT + kpos, KTOT, h, false);
      } else {
        if (!isctx) store_silu_row(a0, a1, (u16*)(ws + OFF_Y) + (size_t)mrow * 1024 + (nb - 2304), h);
      }
    } else {
      const int layer = EPI - 2;
      const float* gate = (const float*)(ws + OFF_MOD) + (layer * 3 + (isctx ? 2 : b)) * 3072 + 2048;
      const float* src; float* dst;
      if (isctx) { src = p.ctx + (size_t)(mrow - MLAT) * 1024; dst = (float*)(ws + OFF_XC1) + (size_t)(mrow - MLAT) * 1024; }
      else { src = (layer == 0 ? p.x : (const float*)p.out) + (size_t)mrow * 1024; dst = p.out + (size_t)mrow * 1024; }
#pragma unroll
      for (int ni = 0; ni < 2; ++ni)
#pragma unroll
        for (int q = 0; q < 4; ++q) {
          const int n = nb + ni * 32 + 8 * q + 4 * h;
          const float4 g4 = *(const float4*)(gate + n);
          const float4 x4 = *(const float4*)(src + n);
          float4 o;
          o.x = x4.x + g4.x * (ni == 0 ? a0[4 * q] : a1[4 * q]);
          o.y = x4.y + g4.y * (ni == 0 ? a0[4 * q + 1] : a1[4 * q + 1]);
          o.z = x4.z + g4.z * (ni == 0 ? a0[4 * q + 2] : a1[4 * q + 2]);
          o.w = x4.w + g4.w * (ni == 0 ? a0[4 * q + 3] : a1[4 * q + 3]);
          *(float4*)(dst + n) = o;
        }
    }
  }
}

template <int EPI>
DI void gemm_tile(const Params& p, const u16* A, const u16* WT, int m0, int n0, unsigned char* smem, uint4& gw0, uint4& gw1, uint4& gw2, uint4& gw3, uint4& ga0, uint4& ga1, uint4& ga2, uint4& ga3, bool pre, int nm0, int nn0, bool has_next) {
  const int t = threadIdx.x, lane = t & 63, w = t >> 6, r = lane & 31, h = lane >> 5;
  const int wn = w & 3, wm = w >> 2;
  constexpr int ST = 256 * 72;
  u16* sW = (u16*)smem;
  u16* sA = sW + 2 * ST;
  f32x16 acc[2][4];
#pragma unroll
  for (int i = 0; i < 2; ++i)
#pragma unroll
    for (int j = 0; j < 4; ++j)
#pragma unroll
      for (int k = 0; k < 16; ++k) acc[i][j][k] = 0.f;
  const u16* gW = WT + (size_t)(n0 + (t >> 3)) * 1024 + (t & 7) * 8;
  const u16* gA = A + (size_t)(m0 + (t >> 3)) * 1024 + (t & 7) * 8;
  const int lo = (t >> 3) * 72 + (t & 7) * 8;
#define GLOADP(PW, PA, k0) { gw0 = *(const uint4*)((PW) + (k0)); gw1 = *(const uint4*)((PW) + 64 * 1024 + (k0)); gw2 = *(const uint4*)((PW) + 128 * 1024 + (k0)); gw3 = *(const uint4*)((PW) + 192 * 1024 + (k0)); \
                             ga0 = *(const uint4*)((PA) + (k0)); ga1 = *(const uint4*)((PA) + 64 * 1024 + (k0)); ga2 = *(const uint4*)((PA) + 128 * 1024 + (k0)); ga3 = *(const uint4*)((PA) + 192 * 1024 + (k0)); }
#define GLOAD(k0) GLOADP(gW, gA, k0)
#define LSTORE(nx) { *(uint4*)(sW + (nx) + lo) = gw0; *(uint4*)(sW + (nx) + lo + 64 * 72) = gw1; *(uint4*)(sW + (nx) + lo + 128 * 72) = gw2; *(uint4*)(sW + (nx) + lo + 192 * 72) = gw3; \
                     *(uint4*)(sA + (nx) + lo) = ga0; *(uint4*)(sA + (nx) + lo + 64 * 72) = ga1; *(uint4*)(sA + (nx) + lo + 128 * 72) = ga2; *(uint4*)(sA + (nx) + lo + 192 * 72) = ga3; }
  const int rot = (blockIdx.x >> 3) & 15;
  if (!pre) GLOAD(rot * 64)
  LSTORE(0)
  GLOAD(((1 + rot) & 15) * 64)
#pragma nounroll
  for (int kt = 0; kt < 16; ++kt) {
    const int cur = kt & 1;
    __syncthreads();
    if (kt < 15) {
      LSTORE((cur ^ 1) * ST)
      if (kt < 14) GLOAD(((kt + 2 + rot) & 15) * 64)
    }
    const u16* cw = sW + cur * ST + (wn * 64 + r) * 72 + h * 8;
    const u16* ca = sA + cur * ST + (wm * 128 + r) * 72 + h * 8;
#pragma unroll
    for (int ks = 0; ks < 4; ++ks) {
      bf16x8 af0 = *(const bf16x8*)(cw + ks * 16), af1 = *(const bf16x8*)(cw + 32 * 72 + ks * 16);
      bf16x8 b0 = *(const bf16x8*)(ca + ks * 16), b1 = *(const bf16x8*)(ca + 32 * 72 + ks * 16);
      bf16x8 b2 = *(const bf16x8*)(ca + 64 * 72 + ks * 16), b3 = *(const bf16x8*)(ca + 96 * 72 + ks * 16);
      acc[0][0] = MFMA(af0, b0, acc[0][0]); acc[0][1] = MFMA(af0, b1, acc[0][1]); acc[0][2] = MFMA(af0, b2, acc[0][2]); acc[0][3] = MFMA(af0, b3, acc[0][3]);
      acc[1][0] = MFMA(af1, b0, acc[1][0]); acc[1][1] = MFMA(af1, b1, acc[1][1]); acc[1][2] = MFMA(af1, b2, acc[1][2]); acc[1][3] = MFMA(af1, b3, acc[1][3]);
    }
  }
  __syncthreads();
  if (has_next) {
    const u16* nW = WT + (size_t)(nn0 + (t >> 3)) * 1024 + (t & 7) * 8;
    const u16* nA = A + (size_t)(nm0 + (t >> 3)) * 1024 + (t & 7) * 8;
    GLOADP(nW, nA, rot * 64)
  }
#undef GLOAD
#undef GLOADP
#undef LSTORE
  gemm_epilogue<EPI>(p, acc, n0 + wn * 64, m0 + wm * 128, r, h);
}

template <int EPI>
DI void gemm_phase(const Params& p, const u16* A, const u16* WT, int mtiles, int ntiles, int srm, unsigned char* smem) {
  const int bpg = gridDim.x >> 3;
  const int xg = blockIdx.x & 7, li = blockIdx.x >> 3;
  const int nsr = (mtiles + srm - 1) / srm;
  const int per_sr = srm * ntiles;
  const int total = nsr * per_sr;
  auto tile_at = [&](int j, int& mt, int& nt) -> bool {
    const int lin = (j * 8 + xg) * bpg + li;
    if (lin >= total || li >= bpg) return false;
    const int sr = lin / per_sr, rem = lin % per_sr;
    nt = rem / srm; mt = sr * srm + rem % srm;
    return mt < mtiles;
  };
  int j = 0, mt = 0, nt = 0; bool have = false;
  for (; j * 8 * bpg < total; ++j) if (tile_at(j, mt, nt)) { have = true; break; }
  uint4 gw0, gw1, gw2, gw3, ga0, ga1, ga2, ga3; bool pre = false;
#pragma nounroll
  while (have) {
    int j2 = j + 1, mt2 = 0, nt2 = 0; bool have2 = false;
    for (; j2 * 8 * bpg < total; ++j2) if (tile_at(j2, mt2, nt2)) { have2 = true; break; }
    gemm_tile<EPI>(p, A, WT, mt * 256, nt * 256, smem, gw0, gw1, gw2, gw3, ga0, ga1, ga2, ga3, pre, mt2 * 256, nt2 * 256, have2);
    pre = have2; have = have2; j = j2; mt = mt2; nt = nt2;
  }
}

template <int MODE>
DI void attn_unit(const u16* Qw, const u16* Kb, const u16* VTb, int nt0, int seg1_lo, int nt1,
                  int tqw  , int qr  , float sinkl2, const float* rpbs,
                  u16* yrow  , unsigned char* smem) {
  const int t = threadIdx.x, lane = t & 63, r = lane & 31, h = lane >> 5;
  constexpr int STG = 2 * 64 * 72;
  u16* sKV = (u16*)smem;
  const int ntiles = nt0 + nt1;
  const int lrow = t >> 3, lc = t & 7;
  const int kofs = lrow * 72 + lc * 8;
  const int vofs0 = 64 * 72 + lrow * 72 + 16 * (lc >> 1) + 4 * (lc & 1), vofs1 = vofs0 + 8;
  uint4 rk, rv;
  const int toff = (MODE == 0) ? (((blockIdx.x >> 3) * nt0) >> 5) : 0;
#define KEY0(i) ((MODE == 0) ? ((((i) + toff) >= nt0 ? (i) + toff - nt0 : (i) + toff) * 64) : (((i) < nt0) ? (i) * 64 : seg1_lo + ((i) - nt0) * 64))
#define TLOAD(i) { const int k0_ = KEY0(i); rk = *(const uint4*)(Kb + (size_t)(k0_ + lrow) * 64 + lc * 8); rv = *(const uint4*)(VTb + (size_t)lrow * KTOT + k0_ + lc * 8); }
#define TSTORE(st) { u16* d_ = sKV + (st) * STG; *(uint4*)(d_ + kofs) = rk; *(uint2*)(d_ + vofs0) = make_uint2(rv.x, rv.y); *(uint2*)(d_ + vofs1) = make_uint2(rv.z, rv.w); }
  TLOAD(0)
  bf16x8 qf[4];
#pragma unroll
  for (int ks = 0; ks < 4; ++ks) qf[ks] = *(const bf16x8*)(Qw + r * 64 + ks * 16 + h * 8);
  TSTORE(0)
  if (ntiles > 1) { TLOAD(1) TSTORE(1) }
  { u16* d_ = sKV + 3 * STG; *(uint2*)(d_ + vofs0) = make_uint2(0u, 0u); *(uint2*)(d_ + vofs1) = make_uint2(0u, 0u); }
  __syncthreads();
  f32x16 o0, o1, sc0, sc1, negm;
#pragma unroll
  for (int i = 0; i < 16; ++i) { o0[i] = 0.f; o1[i] = 0.f; sc0[i] = 0.f; sc1[i] = 0.f; negm[i] = 0.f; }
  {
    const u16* ck = sKV + r * 72 + h * 8;
#pragma unroll
    for (int ks = 0; ks < 4; ++ks) {
      bf16x8 k0f = *(const bf16x8*)(ck + ks * 16), k1f = *(const bf16x8*)(ck + 32 * 72 + ks * 16);
      sc0 = MFMA(k0f, qf[ks], sc0); sc1 = MFMA(k1f, qf[ks], sc1);
    }
  }
  bf16x8 pp[4];
#pragma unroll
  for (int i = 0; i < 4; ++i) pp[i] = bf16x8{0, 0, 0, 0, 0, 0, 0, 0};
  float m = -1e30f, lsum = 0.f;
  float mref_c = 0.f;
  float mref_n = 0.f;
  const int tq = tqw + r;
  const int qc = tq & 63;
  int c0 = qc - 8; c0 = c0 < 0 ? 0 : (c0 > 48 ? 48 : c0);
  int r0w = qr - 4; r0w = r0w < 0 ? 0 : (r0w > 248 ? 248 : r0w);
  bool pend = false; float apend = 1.f;
  uint4 rk2, rv2;
#define TLOADR(i, RK, RV) { const int k0_ = KEY0(i); RK = *(const uint4*)(Kb + (size_t)(k0_ + lrow) * 64 + lc * 8); RV = *(const uint4*)(VTb + (size_t)lrow * KTOT + k0_ + lc * 8); }
#define TSTORER(st, RK, RV) { u16* d_ = sKV + (st) * STG; *(uint4*)(d_ + kofs) = RK; *(uint2*)(d_ + vofs0) = make_uint2(RV.x, RV.y); *(uint2*)(d_ + vofs1) = make_uint2(RV.z, RV.w); }
  constexpr bool DEEP = true;
  { const int i2 = (2 < ntiles) ? 2 : ntiles - 1; TLOADR(i2, rk, rv) }
  if (DEEP) { const int i3 = (3 < ntiles) ? 3 : ntiles - 1; TLOADR(i3, rk2, rv2) }
  auto step = [&](const int i, uint4& lk, uint4& lv) __attribute__((always_inline)) {
    TSTORER((i + 2) & 3, lk, lv)
    if (pend) {
#pragma unroll
      for (int j = 0; j < 16; ++j) { o0[j] *= apend; o1[j] *= apend; if (MODE == 0) negm[j] = -m; }
      if (MODE == 0) mref_n = m;
    }
    { const int ahead = DEEP ? i + 4 : i + 3; const int inx = (ahead < ntiles) ? ahead : ntiles - 1; TLOADR(inx, lk, lv) }
    f32x16 sn0, sn1;
    {
      const u16* ck = sKV + ((i + 1) & 3) * STG + r * 72 + h * 8;
      {
        bf16x8 k0f = *(const bf16x8*)(ck), k1f = *(const bf16x8*)(ck + 32 * 72);
        sn0 = MFMA(k0f, qf[0], negm); sn1 = MFMA(k1f, qf[0], negm);
      }
#pragma unroll
      for (int ks = 1; ks < 4; ++ks) {
        bf16x8 k0f = *(const bf16x8*)(ck + ks * 16), k1f = *(const bf16x8*)(ck + 32 * 72 + ks * 16);
        sn0 = MFMA(k0f, qf[ks], sn0); sn1 = MFMA(k1f, qf[ks], sn1);
      }
    }
    const float mref_next = mref_n;
    const bool seg1 = (i >= nt0);
    const int tk0 = KEY0(i) - NC;
    if (MODE == 1 && seg1) {
#pragma unroll
      for (int j = 0; j < 16; ++j) {
        const int tk = tk0 + crow(j, h);
        int d0 = tq - tk; d0 = d0 < 0 ? -d0 : d0;
        int d1 = tq - (tk + 32); d1 = d1 < 0 ? -d1 : d1;
        if (d0 > 128) sc0[j] = -1e30f;
        if (d1 > 128) sc1[j] = -1e30f;
      }
    }
    if (MODE == 2 && seg1) {
      const int kr = tk0 >> 6;
      const bool rowok = (kr >= r0w) && (kr < r0w + 8);
      int krel = kr - qr + 7; krel = krel < 0 ? 0 : (krel > 14 ? 14 : krel);
      const float* br = rpbs + krel * 31 + 15 - qc;
#pragma unroll
      for (int j = 0; j < 16; ++j) {
        const int kc0 = crow(j, h), kc1 = kc0 + 32;
        const bool v0 = rowok && (kc0 >= c0) && (kc0 < c0 + 16);
        const bool v1 = rowok && (kc1 >= c0) && (kc1 < c0 + 16);
        sc0[j] = v0 ? sc0[j] + br[v0 ? kc0 : qc] : -1e30f;
        sc1[j] = v1 ? sc1[j] + br[v1 ? kc1 : qc] : -1e30f;
      }
    }
    float mt = fmaxf(sc0[0], sc1[0]);
#pragma unroll
    for (int j = 1; j < 16; ++j) mt = fmaxf(fmaxf(mt, sc0[j]), sc1[j]);
    mt = fmaxf(mt, __shfl_xor(mt, 32));
    mt += mref_c;
    const bool resc = __builtin_amdgcn_ballot_w64(mt > m + 8.0f) != 0;
    float alpha = 1.f;
    if (resc) { const float mnew = fmaxf(m, mt); alpha = __builtin_amdgcn_exp2f(m - mnew); m = mnew; lsum *= alpha; }
    if (__builtin_amdgcn_ballot_w64(mref_c != m) != 0) {
      const float dlt = mref_c - m;
#pragma unroll
      for (int j = 0; j < 16; ++j) { sc0[j] += dlt; sc1[j] += dlt; }
    }
    float ps0 = 0.f, ps1 = 0.f;
#pragma unroll
    for (int j = 0; j < 16; ++j) { sc0[j] = __builtin_amdgcn_exp2f(sc0[j]); sc1[j] = __builtin_amdgcn_exp2f(sc1[j]); ps0 += sc0[j]; ps1 += sc1[j]; }
    lsum += ps0 + ps1;
    bf16x8 pc[4];
#pragma unroll
    for (int ss = 0; ss < 2; ++ss) {
      pc[ss] = __builtin_bit_cast(bf16x8, make_uint4(pack2a(sc0[8 * ss + 0], sc0[8 * ss + 1]), pack2a(sc0[8 * ss + 2], sc0[8 * ss + 3]), pack2a(sc0[8 * ss + 4], sc0[8 * ss + 5]), pack2a(sc0[8 * ss + 6], sc0[8 * ss + 7])));
      pc[2 + ss] = __builtin_bit_cast(bf16x8, make_uint4(pack2a(sc1[8 * ss + 0], sc1[8 * ss + 1]), pack2a(sc1[8 * ss + 2], sc1[8 * ss + 3]), pack2a(sc1[8 * ss + 4], sc1[8 * ss + 5]), pack2a(sc1[8 * ss + 6], sc1[8 * ss + 7])));
    }
    {
      const u16* cv = sKV + ((i + 3) & 3) * STG + 64 * 72 + r * 72 + h * 8;
#pragma unroll
      for (int ks = 0; ks < 4; ++ks) {
        bf16x8 v0f = *(const bf16x8*)(cv + ks * 16), v1f = *(const bf16x8*)(cv + 32 * 72 + ks * 16);
        o0 = MFMA(v0f, pp[ks], o0); o1 = MFMA(v1f, pp[ks], o1);
      }
    }
    pend = resc; apend = alpha;
    __syncthreads();
    sc0 = sn0; sc1 = sn1; mref_c = mref_next;
#pragma unroll
    for (int ks = 0; ks < 4; ++ks) pp[ks] = pc[ks];
    };
  if (DEEP) {
#pragma nounroll
    for (int i = 0; i < ntiles; i += 2) { step(i, rk, rv); if (i + 1 < ntiles) step(i + 1, rk2, rv2); }
  } else {
#pragma nounroll
    for (int i = 0; i < ntiles; ++i) step(i, rk, rv);
  }
#undef TLOADR
#undef TSTORER
  if (pend) {
#pragma unroll
    for (int j = 0; j < 16; ++j) { o0[j] *= apend; o1[j] *= apend; }
  }
  {
    const u16* cv = sKV + ((ntiles + 3) & 3) * STG + 64 * 72 + r * 72 + h * 8;
#pragma unroll
    for (int ks = 0; ks < 4; ++ks) {
      bf16x8 v0f = *(const bf16x8*)(cv + ks * 16), v1f = *(const bf16x8*)(cv + 32 * 72 + ks * 16);
      o0 = MFMA(v0f, pp[ks], o0); o1 = MFMA(v1f, pp[ks], o1);
    }
  }
#undef KEY0
#undef TLOAD
#undef TSTORE
  float l = lsum + __shfl_xor(lsum, 32);
  if (MODE == 1) l += __builtin_amdgcn_exp2f(sinkl2 - m);
  const float inv = 1.f / l;
#pragma unroll
  for (int di = 0; di < 2; ++di)
#pragma unroll
    for (int q = 0; q < 4; ++q) {
      const int d0 = di * 32 + 8 * q + 4 * h;
      uint2 g = *(const uint2*)(yrow + d0);
      float v0 = (di == 0 ? o0[4 * q] : o1[4 * q]) * inv * bf2f((u16)(g.x & 0xffff));
      float v1 = (di == 0 ? o0[4 * q + 1] : o1[4 * q + 1]) * inv * bf2f((u16)(g.x >> 16));
      float v2 = (di == 0 ? o0[4 * q + 2] : o1[4 * q + 2]) * inv * bf2f((u16)(g.y & 0xffff));
      float v3 = (di == 0 ? o0[4 * q + 3] : o1[4 * q + 3]) * inv * bf2f((u16)(g.y >> 16));
      *(uint2*)(yrow + d0) = make_uint2(pack2(v0, v1), pack2(v2, v3));
    }
}

typedef float v2f __attribute__((ext_vector_type(2)));
DI v2f cmulv(v2f a, v2f cs, v2f ncs) { return a.xx * cs + a.yy * ncs; }
DI void fft_pass_fwd(float2* buf_, int lm) {
  v2f* buf = (v2f*)buf_;
  const int m = 1 << lm, hm = m >> 1;
  const float rinv = 1.0f / (float)(2 * m);
#pragma unroll 4
  for (int q = 0; q < 8; ++q) {
    const int j = threadIdx.x + 512 * q;
    const int blk = j >> (lm - 1), idx = j & (hm - 1);
    const int i0 = (blk << (lm + 1)) + idx;
    v2f e0 = buf[i0], e1 = buf[i0 + hm], e2 = buf[i0 + m], e3 = buf[i0 + m + hm];
    const float fr = (float)idx * rinv;
    const float c = __builtin_amdgcn_cosf(fr), s = -__builtin_amdgcn_sinf(fr);
    const v2f cs = {c, s}, ncs = {-s, c};
    const float c2 = c * c - s * s, s2 = 2.f * c * s;
    const v2f cs2 = {c2, s2}, ncs2 = {-s2, c2};
    v2f a0 = e0 + e2;
    v2f a2 = cmulv(e0 - e2, cs, ncs);
    v2f a1 = e1 + e3;
    v2f t13 = cmulv(e1 - e3, cs, ncs);
    v2f a3 = {t13.y, -t13.x};
    buf[i0] = a0 + a1;
    buf[i0 + hm] = cmulv(a0 - a1, cs2, ncs2);
    buf[i0 + m] = a2 + a3;
    buf[i0 + m + hm] = cmulv(a2 - a3, cs2, ncs2);
  }
  __syncthreads();
}
DI void fft_pass_inv(float2* buf_, int lm) {
  v2f* buf = (v2f*)buf_;
  const int m = 1 << lm, hm = m >> 1;
  const float rinv = 1.0f / (float)(2 * m);
#pragma unroll 4
  for (int q = 0; q < 8; ++q) {
    const int j = threadIdx.x + 512 * q;
    const int blk = j >> (lm - 1), idx = j & (hm - 1);
    const int i0 = (blk << (lm + 1)) + idx;
    v2f b0 = buf[i0], b1 = buf[i0 + hm], b2 = buf[i0 + m], b3 = buf[i0 + m + hm];
    const float fr = (float)idx * rinv;
    const float c = __builtin_amdgcn_cosf(fr), s = __builtin_amdgcn_sinf(fr);
    const v2f cs = {c, s}, ncs = {-s, c};
    const float c2 = c * c - s * s, s2 = 2.f * c * s;
    const v2f cs2 = {c2, s2}, ncs2 = {-s2, c2};
    v2f t1 = cmulv(b1, cs2, ncs2), t3 = cmulv(b3, cs2, ncs2);
    v2f a0 = b0 + t1, a1 = b0 - t1, a2 = b2 + t3, a3 = b2 - t3;
    v2f u2 = cmulv(a2, cs, ncs);
    v2f u3r = cmulv(a3, cs, ncs);
    v2f u3 = {-u3r.y, u3r.x};
    buf[i0] = a0 + u2;
    buf[i0 + m] = a0 - u2;
    buf[i0 + hm] = a1 + u3;
    buf[i0 + m + hm] = a1 - u3;
  }
  __syncthreads();
}
DI void fft_fwd(float2* buf) {
#pragma nounroll
  for (int lm = 13; lm >= 1; lm -= 2) fft_pass_fwd(buf, lm);
}
DI void fft_inv(float2* buf) {
#pragma nounroll
  for (int lm = 1; lm <= 13; lm += 2) fft_pass_inv(buf, lm);
}
DI float2 cmulf(float2 a, float2 b) { return make_float2(a.x * b.x - a.y * b.y, a.x * b.y + a.y * b.x); }

DI float conv3_bf(const u16* row, int s, float w0, float w1, float w2, float bias) {
  float um = s > 0 ? bf2f(row[s - 1]) : 0.f, u0 = bf2f(row[s]), up = s < S - 1 ? bf2f(row[s + 1]) : 0.f;
  return w0 * um + w1 * u0 + w2 * up + bias;
}
DI float conv3_f(const float* row, int s, int n, float w0, float w1, float w2, float bias) {
  float um = s > 0 ? row[s - 1] : 0.f, u0 = row[s], up = s < n - 1 ? row[s + 1] : 0.f;
  return w0 * um + w1 * u0 + w2 * up + bias;
}

DI float2 unpk(unsigned u) { return make_float2(__uint_as_float(u << 16), __uint_as_float(u & 0xffff0000u)); }
DI void bf4(uint2 v, float (&o)[4]) { o[0] = __uint_as_float(v.x << 16); o[1] = __uint_as_float(v.x & 0xffff0000u); o[2] = __uint_as_float(v.y << 16); o[3] = __uint_as_float(v.y & 0xffff0000u); }
DI void taps4(const u16* ff, const u16* fb, int e0, float (&a)[4], float (&b)[4]) {
  const uint2 fa = *(const uint2*)(ff + e0);
  const uint2 fr = *(const uint2*)(fb + (S - e0 - 4));
  const float b0 = e0 > 0 ? bf2f(fb[S - e0]) : 0.f;
  float r4[4];
  bf4(fa, a); bf4(fr, r4);
  b[0] = b0; b[1] = r4[3]; b[2] = r4[2]; b[3] = r4[1];
}
DI void conv3x4(const u16* row, int e0, float w0, float w1, float w2, float bias, float (&o)[4]) {
  const uint2 c = *(const uint2*)(row + e0);
  const float l = e0 > 0 ? bf2f(row[e0 - 1]) : 0.f;
  const float rr = e0 + 4 < S ? bf2f(row[e0 + 4]) : 0.f;
  float u[4]; bf4(c, u);
  o[0] = w0 * l + w1 * u[0] + w2 * u[1] + bias;
  o[1] = w0 * u[0] + w1 * u[1] + w2 * u[2] + bias;
  o[2] = w0 * u[1] + w1 * u[2] + w2 * u[3] + bias;
  o[3] = w0 * u[2] + w1 * u[3] + w2 * rr + bias;
}
DI void twid(int s, float& c, float& sn) { const float fr = (float)s * (1.0f / 32768.0f); c = __builtin_amdgcn_cosf(fr); sn = -__builtin_amdgcn_sinf(fr); }

DI void hyena_job(const Params& p, int ch, unsigned char* smem) {
  const int t = threadIdx.x;
  float2* buf = (float2*)smem;
  float4* buf4 = (float4*)smem;
  float* red = (float*)(smem + 131072);
  unsigned* spec_e = (unsigned*)(p.ws + OFF_H + (size_t)blockIdx.x * 262144);
  unsigned* spec_o = spec_e + 16384;
  const u16* uT = (const u16*)(p.ws + OFF_UT);
  u16* hgT = (u16*)(p.ws + OFF_HGT);
  const u16* filtT = (const u16*)(p.ws + OFF_FILTT);
  unsigned* zs = spec_e + 32768;
#define E0(q) (4 * (t + 512 * (q)))
#define LDS_GET(e0, v0, v1, v2, v3) { const float4 A_ = buf4[(e0) >> 1], B_ = buf4[((e0) >> 1) + 1]; v0 = make_float2(A_.x, A_.y); v1 = make_float2(A_.z, A_.w); v2 = make_float2(B_.x, B_.y); v3 = make_float2(B_.z, B_.w); }
#define LDS_PUT(e0, v0, v1, v2, v3) { buf4[(e0) >> 1] = make_float4(v0.x, v0.y, v1.x, v1.y); buf4[((e0) >> 1) + 1] = make_float4(v2.x, v2.y, v3.x, v3.y); }
#pragma nounroll
  for (int o = 0; o < 2; ++o) {
    const u16* ff = filtT + (size_t)(o * 1024 + ch) * S;
    const u16* fb = filtT + (size_t)(o * 1024 + 512 + ch) * S;
    const float dsk = p.skip[o * 512 + ch];
    __syncthreads();
    float ss = 0.f;
#pragma unroll 2
    for (int q = 0; q < 8; ++q) {
      const int e0 = E0(q);
      float a[4], b[4]; taps4(ff, fb, e0, a, b);
#pragma unroll
      for (int k = 0; k < 4; ++k) ss += a[k] * a[k] + b[k] * b[k];
      LDS_PUT(e0, make_float2(a[0] + b[0], 0.f), make_float2(a[1] + b[1], 0.f), make_float2(a[2] + b[2], 0.f), make_float2(a[3] + b[3], 0.f))
    }
    const float rnorm = rsqrtf(block_sum(ss, red) + EPSF);
    __syncthreads();
    fft_fwd(buf);
#pragma unroll 2
    for (int q = 0; q < 8; ++q) {
      const int e0 = E0(q);
      float a[4], b[4]; taps4(ff, fb, e0, a, b);
      float2 v0, v1, v2, v3; LDS_GET(e0, v0, v1, v2, v3)
      *(uint4*)(spec_e + e0) = make_uint4(pack2(v0.x, v0.y), pack2(v1.x, v1.y), pack2(v2.x, v2.y), pack2(v3.x, v3.y));
      float2 w[4];
#pragma unroll
      for (int k = 0; k < 4; ++k) { float c, sn; twid(e0 + k, c, sn); const float d = a[k] - b[k]; w[k] = make_float2(d * c, d * sn); }
      LDS_PUT(e0, w[0], w[1], w[2], w[3])
    }
    __syncthreads();
    fft_fwd(buf);
    if (o == 0) {
      const u16* u0 = uT + (size_t)(0 * 1536 + ch) * S;
      const u16* u1 = uT + (size_t)(1 * 1536 + ch) * S;
      const float cw0 = p.cw[0 * 1536 + ch], cw1 = p.cw[1 * 1536 + ch], cw2 = p.cw[2 * 1536 + ch], cbv = p.cb[ch];
#pragma unroll 2
      for (int q = 0; q < 8; ++q) {
        const int e0 = E0(q);
        float za[4], zb[4]; conv3x4(u0, e0, cw0, cw1, cw2, cbv, za); conv3x4(u1, e0, cw0, cw1, cw2, cbv, zb);
        float2 v0, v1, v2, v3; LDS_GET(e0, v0, v1, v2, v3)
        *(uint4*)(spec_o + e0) = make_uint4(pack2(v0.x, v0.y), pack2(v1.x, v1.y), pack2(v2.x, v2.y), pack2(v3.x, v3.y));
        *(uint4*)(zs + e0) = make_uint4(pack2(za[0], zb[0]), pack2(za[1], zb[1]), pack2(za[2], zb[2]), pack2(za[3], zb[3]));
        LDS_PUT(e0, make_float2(za[0], zb[0]), make_float2(za[1], zb[1]), make_float2(za[2], zb[2]), make_float2(za[3], zb[3]))
      }
    } else {
#pragma unroll 2
      for (int q = 0; q < 8; ++q) {
        const int e0 = E0(q);
        const uint4 uz = *(const uint4*)(zs + e0);
        float2 v0, v1, v2, v3; LDS_GET(e0, v0, v1, v2, v3)
        *(uint4*)(spec_o + e0) = make_uint4(pack2(v0.x, v0.y), pack2(v1.x, v1.y), pack2(v2.x, v2.y), pack2(v3.x, v3.y));
        LDS_PUT(e0, unpk(uz.x), unpk(uz.y), unpk(uz.z), unpk(uz.w))
      }
    }
    __syncthreads();
    fft_fwd(buf);
#pragma unroll 2
    for (int q = 0; q < 8; ++q) {
      const int e0 = E0(q);
      const uint4 us = *(const uint4*)(spec_e + e0);
      float2 v0, v1, v2, v3; LDS_GET(e0, v0, v1, v2, v3)
      LDS_PUT(e0, cmulf(v0, unpk(us.x)), cmulf(v1, unpk(us.y)), cmulf(v2, unpk(us.z)), cmulf(v3, unpk(us.w)))
    }
    __syncthreads();
    fft_inv(buf);
#pragma unroll 2
    for (int q = 0; q < 8; ++q) {
      const int e0 = E0(q);
      const uint4 uz = *(const uint4*)(zs + e0);
      float2 v0, v1, v2, v3; LDS_GET(e0, v0, v1, v2, v3)
      *(uint4*)(spec_e + e0) = make_uint4(pack2(v0.x, v0.y), pack2(v1.x, v1.y), pack2(v2.x, v2.y), pack2(v3.x, v3.y));
      const float2 z[4] = {unpk(uz.x), unpk(uz.y), unpk(uz.z), unpk(uz.w)};
      float2 w[4];
#pragma unroll
      for (int k = 0; k < 4; ++k) { float c, sn; twid(e0 + k, c, sn); w[k] = make_float2(z[k].x * c - z[k].y * sn, z[k].x * sn + z[k].y * c); }
      LDS_PUT(e0, w[0], w[1], w[2], w[3])
    }
    __syncthreads();
    fft_fwd(buf);
#pragma unroll 2
    for (int q = 0; q < 8; ++q) {
      const int e0 = E0(q);
      const uint4 us = *(const uint4*)(spec_o + e0);
      float2 v0, v1, v2, v3; LDS_GET(e0, v0, v1, v2, v3)
      LDS_PUT(e0, cmulf(v0, unpk(us.x)), cmulf(v1, unpk(us.y)), cmulf(v2, unpk(us.z)), cmulf(v3, unpk(us.w)))
    }
    __syncthreads();
    fft_inv(buf);
    const int xc = 512 * (o + 1) + ch;
    const u16* x0r = uT + (size_t)(0 * 1536 + xc) * S;
    const u16* x1r = uT + (size_t)(1 * 1536 + xc) * S;
    const float xw0 = p.cw[0 * 1536 + xc], xw1 = p.cw[1 * 1536 + xc], xw2 = p.cw[2 * 1536 + xc], xbv = p.cb[xc];
    const float sc = rnorm * (1.0f / 32768.0f);
    u16* hg0 = hgT + (size_t)(0 * 512 + ch) * S;
    u16* hg1 = hgT + (size_t)(1 * 512 + ch) * S;
#pragma unroll 2
    for (int q = 0; q < 8; ++q) {
      const int e0 = E0(q);
      const uint4 ue = *(const uint4*)(spec_e + e0);
      const uint4 uz = *(const uint4*)(zs + e0);
      float g0[4], g1[4]; conv3x4(x0r, e0, xw0, xw1, xw2, xbv, g0); conv3x4(x1r, e0, xw0, xw1, xw2, xbv, g1);
      float h0[4] = {1.f, 1.f, 1.f, 1.f}, h1[4] = {1.f, 1.f, 1.f, 1.f};
      if (o == 1) { bf4(*(const uint2*)(hg0 + e0), h0); bf4(*(const uint2*)(hg1 + e0), h1); }
      float2 yo[4]; LDS_GET(e0, yo[0], yo[1], yo[2], yo[3])
      const float2 ye[4] = {unpk(ue.x), unpk(ue.y), unpk(ue.z), unpk(ue.w)};
      const float2 z[4] = {unpk(uz.x), unpk(uz.y), unpk(uz.z), unpk(uz.w)};
      float r0[4], r1[4];
#pragma unroll
      for (int k = 0; k < 4; ++k) {
        float c, sn; twid(e0 + k, c, sn); sn = -sn;
        const float y0 = (ye[k].x + yo[k].x * c - yo[k].y * sn) * sc;
        const float y1 = (ye[k].y + yo[k].x * sn + yo[k].y * c) * sc;
        r0[k] = g0[k] * (y0 + z[k].x * dsk) * h0[k]; r1[k] = g1[k] * (y1 + z[k].y * dsk) * h1[k];
      }
      if (o == 0) *(uint4*)(zs + e0) = make_uint4(pack2(r0[0], r1[0]), pack2(r0[1], r1[1]), pack2(r0[2], r1[2]), pack2(r0[3], r1[3]));
      else {
        *(uint2*)(hg0 + e0) = make_uint2(pack2(r0[0], r0[1]), pack2(r0[2], r0[3]));
        *(uint2*)(hg1 + e0) = make_uint2(pack2(r1[0], r1[1]), pack2(r1[2], r1[3]));
      }
    }
    __syncthreads();
  }
#undef E0
#undef LDS_GET
#undef LDS_PUT
  {
    float* sm = (float*)smem;
    float* hf = sm;
    float* hb = sm + 256;
    float* zc = sm + 512;
    const float* utc = (const float*)(p.ws + OFF_UTC);
    const float* hgc = (const float*)(p.ws + OFF_HGTC);
    const float* flc = (const float*)(p.ws + OFF_FILTTC);
    const int b = t >> 8, tt = t & 255;
    const float cw0 = p.cw[0 * 1536 + ch], cw1 = p.cw[1 * 1536 + ch], cw2 = p.cw[2 * 1536 + ch], cbv = p.cb[ch];
    __syncthreads();
    zc[b * 256 + tt] = conv3_f(utc + (size_t)(b * 1536 + ch) * NC, tt, NC, cw0, cw1, cw2, cbv);
    for (int o = 0; o < 2; ++o) {
      float tap = flc[(size_t)(o * 1024 + b * 512 + ch) * NC + tt];
      float sq = (b == 1 && tt == 0) ? 0.f : tap * tap;
      const float rnorm = rsqrtf(block_sum(sq, red) + EPSF);
      if (b == 0) sm[255 + tt] = tap; else if (tt > 0) sm[255 - tt] = tap;
      __syncthreads();
      float a = 0.f;
      {
        const float* tp = sm + 255 + tt;
        const float4* z4 = (const float4*)(zc + b * 256);
#pragma unroll 4
        for (int s4 = 0; s4 < 64; ++s4) {
          const float4 zv = z4[s4];
          a += tp[-(4 * s4)] * zv.x; a += tp[-(4 * s4 + 1)] * zv.y; a += tp[-(4 * s4 + 2)] * zv.z; a += tp[-(4 * s4 + 3)] * zv.w;
        }
      }
      const int xc = 512 * (o + 1) + ch;
      const float g = conv3_f(utc + (size_t)(b * 1536 + xc) * NC, tt, NC, p.cw[0 * 1536 + xc], p.cw[1 * 1536 + xc], p.cw[2 * 1536 + xc], p.cb[xc]);
      const float res = g * (a * rnorm + zc[b * 256 + tt] * p.skip[o * 512 + ch]);
      __syncthreads();
      if (o == 0) zc[b * 256 + tt] = res;
      else {
        const float hg = hgc[(size_t)(b * 512 + ch) * NC + tt];
        ((u16*)(p.ws + OFF_Y))[(size_t)(MLAT + b * NC + tt) * 1024 + 512 + ch] = f2bf(res * hg);
      }
      __syncthreads();
    }
  }
}

DI void phase3(const Params& p, unsigned char* smem, bool do_h, bool do_a) {
  const int w = threadIdx.x >> 6, lane = threadIdx.x & 63, r = lane & 31;
#pragma nounroll
  for (int it = blockIdx.x; it < (do_h ? 512 : 0); it += gridDim.x) hyena_job(p, it, smem);
#pragma nounroll
  for (int it = blockIdx.x; it < (do_a ? 1024 + 16 : 0); it += gridDim.x) {
    __syncthreads();
    const bool isc = it >= 1024;
    const int u = isc ? it - 1024 : it;
    const int b = isc ? (u >> 3) : (u >> 9), kvh = isc ? ((u >> 2) & 1) : ((u >> 8) & 1), qt = isc ? (u & 3) : (u & 255);
    const int head = kvh * 4 + (w >> 1); const int q0 = qt * 64 + (w & 1) * 32;
    const u16* Qw = isc ? (const u16*)(p.ws + OFF_QC) + ((size_t)(b * 8 + head) * NC + q0) * 64
                        : (const u16*)(p.ws + OFF_Q) + ((size_t)(b * 8 + head) * S + q0) * 64;
    u16* yrow = (u16*)(p.ws + OFF_Y) + (size_t)((isc ? MLAT + b * NC : b * S) + q0 + r) * 1024 + head * 64;
    attn_unit<0>(Qw, (const u16*)(p.ws + OFF_K) + (size_t)(b * 2 + kvh) * KTOT * 64,
                 (const u16*)(p.ws + OFF_VT) + (size_t)(b * 2 + kvh) * 64 * KTOT,
                 isc ? NC / 64 : KTOT / 64, 0, 0, q0, 0, 0.f, nullptr, yrow, smem);
  }
}

DI void phase4(const Params& p, unsigned char* smem) {
  u16* tile = (u16*)smem;
  const u16* src = (const u16*)(p.ws + OFF_HGT);
  u16* y = (u16*)(p.ws + OFF_Y);
  const int t = threadIdx.x;
  if (blockIdx.x < 8) { uint4 q0_, q1_, q2_, q3_, q4_, q5_, q6_, q7_; gemm_tile<2>(p, (const u16*)(p.ws + OFF_Y), (const u16*)(p.ws + OFF_WOUTT), MLAT + (blockIdx.x >> 2) * 256, (blockIdx.x & 3) * 256, smem, q0_, q1_, q2_, q3_, q4_, q5_, q6_, q7_, false, 0, 0, false); return; }
  for (int it = blockIdx.x - 8; it < 4096; it += gridDim.x - 8) {
    const int b = it >> 11, ct = (it >> 8) & 7, st = it & 255;
    __syncthreads();
#pragma unroll
    for (int i = 0; i < 8; ++i) { int e = t + 512 * i; int c = e >> 6, s = e & 63; tile[c * 66 + s] = src[(size_t)(b * 512 + ct * 64 + c) * S + st * 64 + s]; }
    __syncthreads();
#pragma unroll
    for (int i = 0; i < 8; ++i) { int e = t + 512 * i; int s = e >> 6, c = e & 63; y[(size_t)(b * S + st * 64 + s) * 1024 + 512 + ct * 64 + c] = tile[c * 66 + s]; }
  }
}

DI void phase8(const Params& p, unsigned char* smem) {
  const int w = threadIdx.x >> 6, lane = threadIdx.x & 63, r = lane & 31;
  float* rpbs = (float*)(smem + 73728);
  for (int it = blockIdx.x; it < 2048; it += gridDim.x) {
    __syncthreads();
    if (it < 1024) {
      const int u = it; const int b = u >> 9, kvh = (u >> 8) & 1, qt = u & 255;
      const int head = kvh * 4 + (w >> 1); const int q0 = qt * 64 + (w & 1) * 32;
      int lo = qt * 64 - 128; if (lo < 0) lo = 0;
      int hi = qt * 64 + 192; if (hi > S) hi = S;
      attn_unit<1>((const u16*)(p.ws + OFF_QW) + ((size_t)(b * 8 + head) * S + q0) * 64,
                   (const u16*)(p.ws + OFF_KW) + (size_t)(b * 2 + kvh) * KTOT * 64,
                   (const u16*)(p.ws + OFF_VWT) + (size_t)(b * 2 + kvh) * 64 * KTOT,
                   NC / 64, NC + lo, (hi - lo) / 64, q0, 0, p.sink[head] * LOG2E, nullptr,
                   (u16*)(p.ws + OFF_Y) + (size_t)(b * S + q0 + r) * 1024 + head * 64, smem);
    } else {
      const int u = it - 1024; const int b = u >> 9, head = (u >> 6) & 7, rt = u & 63;
      const int R0 = rt * 4;
      for (int e = threadIdx.x; e < 465; e += 512) rpbs[e] = p.rpb[head * 465 + e] * LOG2E;
      int rlo = R0 - 4; rlo = rlo < 0 ? 0 : (rlo > 248 ? 248 : rlo);
      int rhi = R0 + 3 - 4; rhi = rhi < 0 ? 0 : (rhi > 248 ? 248 : rhi); rhi += 7;
      const int qr = R0 + (w >> 1); const int q0 = qr * 64 + (w & 1) * 32;
      attn_unit<2>((const u16*)(p.ws + OFF_QN) + ((size_t)(b * 8 + head) * S + q0) * 64,
                   (const u16*)(p.ws + OFF_KN) + (size_t)(b * 8 + head) * KTOT * 64,
                   (const u16*)(p.ws + OFF_VNT) + (size_t)(b * 8 + head) * 64 * KTOT,
                   NC / 64, NC + rlo * 64, rhi - rlo + 1, q0, qr, 0.f, rpbs,
                   (u16*)(p.ws + OFF_Y) + (size_t)(b * S + q0 + r) * 1024 + 512 + head * 64, smem);
    }
  }
}

#define XB_TMO      128
#define XB_XCNT(j)  (256  + 64 * (j))
#define XB_XSUB(j)  (1280 + 64 * (j))
#define XB_XGEN(j)  (2304 + 64 * (j))
#define XB_TOP      3328
#define XB_TOPGEN   3392
#define XCD_BAR_WORDS 3456
#define XB_SPIN_CAP (1u << 18)
#define LAS __attribute__((address_space(3)))

__device__ __forceinline__ unsigned xb_ld(unsigned* p)              { return __hip_atomic_load(p, __ATOMIC_RELAXED, __HIP_MEMORY_SCOPE_AGENT); }
__device__ __forceinline__ unsigned xb_add(unsigned* p, unsigned v) { return __hip_atomic_fetch_add(p, v, __ATOMIC_RELAXED, __HIP_MEMORY_SCOPE_AGENT); }
__device__ __forceinline__ unsigned xb_xcc_id() { return (unsigned)__builtin_amdgcn_s_getreg((3 << 11) | 20) & 0xFu; }
#define XB_SPIN(cond, bar) do { unsigned _sp = 0; while (cond) { __builtin_amdgcn_s_sleep(1); \
    if ((++_sp & 255u) == 0u) { if (xb_ld(&(bar)[XB_TMO])) break; if (_sp > XB_SPIN_CAP) { atomicAdd(&(bar)[XB_TMO], 1u); break; } } } } while (0)

struct XcdBarrier {
    unsigned* bar; unsigned x;
    volatile LAS unsigned* st;
};

__device__ __forceinline__ XcdBarrier xcd_barrier_post(unsigned* bar, volatile LAS unsigned* st) {
    XcdBarrier b; b.bar = bar; b.x = xb_xcc_id(); b.st = st;
    if (threadIdx.x == 0) (void)xb_add(&bar[XB_XCNT(b.x)], 1u);
    return b;
}
__device__ __forceinline__ void xcd_barrier_complete(unsigned* bar, unsigned x, unsigned& nloc, unsigned& nx) {
    const unsigned G = gridDim.x * gridDim.y * gridDim.z;
    unsigned sum, cnt, mine, sp = 0u;
    for (;;) {
        sum = 0u; cnt = 0u; mine = 0u;
#pragma unroll
        for (unsigned j = 0; j < 16; ++j) { const unsigned c = xb_ld(&bar[XB_XCNT(j)]); sum += c; cnt += (c > 0u) ? 1u : 0u; mine = (j == x) ? c : mine; }
        if (sum == G) break;
        __builtin_amdgcn_s_sleep(1);
        if ((++sp & 255u) == 0u) { if (xb_ld(&bar[XB_TMO])) break; if (sp > XB_SPIN_CAP) { atomicAdd(&bar[XB_TMO], 1u); break; } }
    }
    nloc = mine > 0u ? mine : 1u; nx = cnt > 0u ? cnt : 1u;
}

__device__ __forceinline__ void xcd_barrier(const XcdBarrier& b) {
    asm volatile("s_waitcnt vmcnt(0)" ::: "memory");
    __syncthreads();
    if (threadIdx.x == 0) {
        unsigned* bar = b.bar;
        __builtin_amdgcn_s_waitcnt(0);
        unsigned nloc = b.st[0], nx = b.st[1];
        if (nloc == 0u) { xcd_barrier_complete(bar, b.x, nloc, nx); b.st[0] = nloc; b.st[1] = nx; }
        const unsigned old = xb_add(&bar[XB_XSUB(b.x)], 1u);
        const unsigned gen = old / nloc;
        if (old + 1u == (gen + 1u) * nloc) {
            __builtin_amdgcn_fence(__ATOMIC_RELEASE, "agent");
            asm volatile("s_waitcnt vmcnt(0)" ::: "memory");
            const unsigned og = xb_add(&bar[XB_TOP], 1u);
            const unsigned tg = og / nx;
            if (og + 1u == (tg + 1u) * nx) xb_add(&bar[XB_TOPGEN], 1u);
            else XB_SPIN(xb_ld(&bar[XB_TOPGEN]) == tg, bar);
            __builtin_amdgcn_fence(__ATOMIC_ACQUIRE, "agent");
            xb_add(&bar[XB_XGEN(b.x)], 1u);
            asm volatile("s_waitcnt vmcnt(0)" ::: "memory");
        } else {
            XB_SPIN(xb_ld(&bar[XB_XGEN(b.x)]) == gen, bar);
            __builtin_amdgcn_fence(__ATOMIC_ACQUIRE, "agent");
            asm volatile("s_waitcnt vmcnt(0)" ::: "memory");
        }
    }
    __syncthreads();
}


__global__ void __launch_bounds__(NTHR) hybrid_fwd(Params p) {
  extern __shared__ __attribute__((aligned(16))) unsigned char smem[];
  cg::grid_group grid = cg::this_grid();
  const u16* h = (const u16*)(p.ws + OFF_H);
  const u16* y = (const u16*)(p.ws + OFF_Y);
  const u16* winT = (const u16*)(p.ws + OFF_WINT);
  const u16* woutT = (const u16*)(p.ws + OFF_WOUTT);
#ifndef PROBE
#define PROBE 0
#endif
  volatile LAS unsigned* xst = (volatile LAS unsigned*)(smem + 147456);
  if (threadIdx.x == 0) { xst[0] = 0u; xst[1] = 0u; xst[2] = 0u; xst[3] = 0u; }
  __syncthreads();
  const XcdBarrier xb = xcd_barrier_post((unsigned*)(p.ws + OFF_BAR), xst);
#define STEP(stmt) if (PH(__LINE__)) { stmt; xcd_barrier(xb); }
  if (p.phase_hi < 0) grid.sync();
  STEP(phase0(p, smem))
  STEP(phase1(p, smem))
#if PROBE == 8
  for (int i = 0; i < 10; ++i) grid.sync();
#endif
  STEP(gemm_phase<0>(p, h, winT, MALL / 256, INW / 256, 4, smem))
#if PROBE == 1
  STEP(phase3(p, smem, false, true))
  STEP(gemm_phase<0>(p, h, winT, MALL / 256, INW / 256, 4, smem))
#endif
#if PROBE == 7
  STEP(phase3(p, smem, true, false))
  STEP(phase1(p, smem))
  STEP(gemm_phase<0>(p, h, winT, MALL / 256, INW / 256, 4, smem))
#endif
  STEP(phase3(p, smem, true, true))
#if PROBE == 6
  STEP(phase1(p, smem))
#endif
#if PROBE == 2
  STEP(phase1(p, smem))
  STEP(gemm_phase<0>(p, h, winT, MALL / 256, INW / 256, 4, smem))
  STEP(phase3(p, smem, true, true))
#endif
  STEP(phase4(p, smem))
  STEP(gemm_phase<2>(p, y, woutT, MLAT / 256, 4, 8, smem))
#if PROBE == 4
  STEP(gemm_phase<2>(p, y, woutT, MLAT / 256, 4, 8, smem))
#endif
  STEP(for (int it = blockIdx.x; it < 2080; it += gridDim.x) modnorm_rows(p, 1, it))
  STEP(gemm_phase<1>(p, h, winT + (size_t)INW * 1024, MALL / 256, INW / 256, 4, smem))
#if PROBE == 3
  STEP(gemm_phase<1>(p, h, winT + (size_t)INW * 1024, MALL / 256, INW / 256, 4, smem))
#endif
#if PROBE == 5
  STEP(phase8(p, smem))
  STEP(gemm_phase<1>(p, h, winT + (size_t)INW * 1024, MALL / 256, INW / 256, 4, smem))
#endif
  STEP(phase8(p, smem))
  gemm_phase<3>(p, y, woutT + (size_t)1024 * 1024, MLAT / 256, 4, 8, smem);
}

extern "C" void kernel_launch(void* const* d_in, const int* in_sizes, int n_in, void* d_out, int out_size, void* d_ws, size_t ws_size, hipStream_t stream) {
  static int grid_blocks = 0;
  if (grid_blocks == 0) {
    if (n_in != 26 || ws_size < WS_NEED) { fprintf(stderr, "kernel_launch: unexpected n_in %d or ws_size %zu (need %zu)\n", n_in, ws_size, (size_t)WS_NEED); grid_blocks = -1; return; }
    int dev = 0, cus = 0, per_cu = 0;
    hipGetDevice(&dev);
    hipDeviceGetAttribute(&cus, hipDeviceAttributeMultiprocessorCount, dev);
    if (hipFuncSetAttribute((const void*)hybrid_fwd, hipFuncAttributeMaxDynamicSharedMemorySize, LDS_BYTES) != hipSuccess) { fprintf(stderr, "kernel_launch: hipFuncSetAttribute failed\n"); grid_blocks = -1; return; }
    if (hipOccupancyMaxActiveBlocksPerMultiprocessor(&per_cu, (const void*)hybrid_fwd, NTHR, LDS_BYTES) != hipSuccess || per_cu < 1) { fprintf(stderr, "kernel_launch: occupancy query failed (%d)\n", per_cu); grid_blocks = -1; return; }
    int g = cus * per_cu; if (g > 256) g = 256;
    grid_blocks = g;
  }
  if (grid_blocks < 0) return;
  Params p{};
  const float* const* in = (const float* const*)d_in;
  p.x = in[0]; p.c = in[1]; p.ctx = in[2]; p.c_ctx = in[3]; p.norm_g = in[4]; p.w_ada = in[5]; p.b_ada = in[6]; p.w_in = in[7]; p.w_out = in[8];
  p.gq = in[9]; p.gk = in[10]; p.cw = in[11]; p.cb = in[12]; p.w1 = in[13]; p.b1 = in[14]; p.w2 = in[15]; p.b2 = in[16]; p.fr = in[17]; p.w3 = in[18]; p.skip = in[19];
  p.wqn = in[20]; p.wkn = in[21]; p.sink = in[22]; p.nqn = in[23]; p.nkn = in[24]; p.rpb = in[25];
  p.out = (float*)d_out; p.ws = (unsigned char*)d_ws;
  p.phase_lo = 0; p.phase_hi = 10;
  if (hipMemsetAsync((unsigned char*)d_ws + OFF_BAR, 0, XCD_BAR_WORDS * sizeof(unsigned), stream) != hipSuccess) { fprintf(stderr, "kernel_launch: memset of the barrier words failed\n"); return; }
  void* args[] = {&p};
  hipError_t e = hipLaunchCooperativeKernel((const void*)hybrid_fwd, dim3(grid_blocks), dim3(NTHR), args, LDS_BYTES, stream);
  if (e != hipSuccess) fprintf(stderr, "kernel_launch: cooperative launch failed: %s (grid %d)\n", hipGetErrorString(e), grid_blocks);
}
```

```cpp
#include <hip/hip_runtime.h>
#include <hip/hip_cooperative_groups.h>
#include <cstdio>
#include <cstdint>
namespace cg = cooperative_groups;

typedef unsigned short u16;
using bf16x8 = __attribute__((ext_vector_type(8))) short;
using f32x16 = __attribute__((ext_vector_type(16))) float;
typedef __bf16 bf16x2_t __attribute__((ext_vector_type(2)));
#define DI __device__ __forceinline__
#define MFMA(a, b, c) __builtin_amdgcn_mfma_f32_32x32x16_bf16((a), (b), (c), 0, 0, 0)

constexpr int S = 16384, DM = 1024, NB = 2, NC = 256, INW = 3328;
constexpr int KTOT = S + NC;
constexpr int MLAT = NB * S;
constexpr int MALL = MLAT + NB * NC;
constexpr int NTHR = 512;
constexpr float LOG2E = 1.4426950408889634f;
constexpr float QSCALE = 0.125f * LOG2E;
constexpr float EPSF = 1e-6f;
constexpr size_t MiB = 1024 * 1024;
constexpr size_t OFF_MOD = 0;
constexpr size_t OFF_ROPE = 128 * 1024;
constexpr size_t OFF_BAR = 512 * 1024;
constexpr size_t OFF_WINT = 1 * MiB;
constexpr size_t OFF_WOUTT = 15 * MiB;
constexpr size_t OFF_HDN2 = 19 * MiB;
constexpr size_t OFF_HDN2C = 23 * MiB;
constexpr size_t OFF_XC1 = 24 * MiB;
constexpr size_t OFF_FILTTC = 26 * MiB;
constexpr size_t OFF_QC = 28 * MiB;
constexpr size_t OFF_UTC = 29 * MiB;
constexpr size_t OFF_HGTC = 32 * MiB;
constexpr size_t OFF_H = 34 * MiB;
constexpr size_t OFF_Y = 99 * MiB;
constexpr size_t OFF_FILTT = 164 * MiB;
constexpr size_t OFF_Q = 292 * MiB;
constexpr size_t OFF_K = 324 * MiB;
constexpr size_t OFF_VT = 333 * MiB;
constexpr size_t OFF_UT = 342 * MiB;
constexpr size_t OFF_HGT = 438 * MiB;
constexpr size_t WS_NEED = 470 * MiB;
constexpr size_t OFF_QW = 164 * MiB;
constexpr size_t OFF_KW = 196 * MiB;
constexpr size_t OFF_VWT = 205 * MiB;
constexpr size_t OFF_QN = 214 * MiB;
constexpr size_t OFF_KN = 246 * MiB;
constexpr size_t OFF_VNT = 279 * MiB;
constexpr int LDS_BYTES = 147456 + 16;

#ifndef ONLY_PHASE
#define ONLY_PHASE -1
#endif
#define PH(k) (ONLY_PHASE < 0 || ONLY_PHASE == (k))
struct Params {
  const float *x, *c, *ctx, *c_ctx, *norm_g, *w_ada, *b_ada, *w_in, *w_out;
  const float *gq, *gk, *cw, *cb, *w1, *b1, *w2, *b2, *fr, *w3, *skip;
  const float *wqn, *wkn, *sink, *nqn, *nkn, *rpb;
  float* out;
  unsigned char* ws;
  int phase_lo, phase_hi;
};

DI unsigned pack2(float a, float b) { bf16x2_t v = {(__bf16)a, (__bf16)b}; return __builtin_bit_cast(unsigned, v); }
DI unsigned pack2a(float a, float b) { unsigned r; asm("v_cvt_pk_bf16_f32 %0, %1, %2" : "=v"(r) : "v"(a), "v"(b)); return r; }
DI u16 f2bf(float a) { return __builtin_bit_cast(u16, (__bf16)a); }
DI float bf2f(u16 v) { return __uint_as_float(((unsigned)v) << 16); }
DI float siluf(float v) { return v / (1.f + __expf(-v)); }
DI int crow(int reg, int h) { return (reg & 3) + 8 * (reg >> 2) + 4 * h; }
DI float wave_sum(float v) {
#pragma unroll
  for (int o = 32; o >= 1; o >>= 1) v += __shfl_xor(v, o);
  return v;
}
DI float block_sum(float v, float* red) {
  v = wave_sum(v);
  __syncthreads();
  if ((threadIdx.x & 63) == 0) red[threadIdx.x >> 6] = v;
  __syncthreads();
  float s = 0.f;
#pragma unroll
  for (int i = 0; i < 8; ++i) s += red[i];
  return s;
}

DI void p0_transpose(const float* W, int K, int N, u16* WT, int k0, int n0, float* tile) {
  const int t = threadIdx.x;
  __syncthreads();
#pragma unroll
  for (int i = 0; i < 8; ++i) { int e = t + 512 * i; int kk = e >> 6, nn = e & 63; tile[kk * 65 + nn] = W[(size_t)(k0 + kk) * N + n0 + nn]; }
  __syncthreads();
#pragma unroll
  for (int i = 0; i < 8; ++i) { int e = t + 512 * i; int nn = e >> 6, kk = e & 63; WT[(size_t)(n0 + nn) * K + k0 + kk] = f2bf(tile[kk * 65 + nn]); }
}

DI void p0_adaln(const Params& p, int l, int nc, float* sm) {
  const int t = threadIdx.x;
  float* mod = (float*)(p.ws + OFF_MOD);
  __syncthreads();
  for (int e = t; e < 3072; e += 512) { int v = e >> 10, k = e & 1023; float cv = v < 2 ? p.c[v * 1024 + k] : p.c_ctx[k]; sm[e] = cv / (1.f + expf(-cv)); }
  __syncthreads();
  const int n = t & 63, kg = t >> 6;
  const float* W = p.w_ada + (size_t)l * 1024 * 3072 + nc * 64 + n;
  float a0 = 0.f, a1 = 0.f, a2 = 0.f;
  for (int k = kg * 128; k < kg * 128 + 128; ++k) { float w = W[(size_t)k * 3072]; a0 += sm[k] * w; a1 += sm[1024 + k] * w; a2 += sm[2048 + k] * w; }
  float* red = sm + 3072;
  red[(kg * 3 + 0) * 64 + n] = a0; red[(kg * 3 + 1) * 64 + n] = a1; red[(kg * 3 + 2) * 64 + n] = a2;
  __syncthreads();
  if (t < 192) {
    int v = t >> 6; float s = 0.f;
    for (int g = 0; g < 8; ++g) s += red[(g * 3 + v) * 64 + n];
    mod[(l * 3 + v) * 3072 + nc * 64 + n] = s + p.b_ada[l * 3072 + nc * 64 + n];
  }
}

DI void p0_mlp(const Params& p, int tbase, int n, float* dst, float* sm) {
  const int t = threadIdx.x, tl = t >> 6, j = t & 63;
  float* zs = sm;
  float* hs = sm + 8 * 36;
  float* w1s = sm + 1024;
  float* w2s = w1s + 33 * 64;
  __syncthreads();
  for (int e = t; e < 33 * 64; e += 512) w1s[e] = p.w1[e];
  for (int e = t; e < 64 * 64; e += 512) w2s[e] = p.w2[e];
  const float frj = p.fr[j], b1j = p.b1[j], b2j = p.b2[j];
#pragma nounroll
  for (int g = 0; g < 8; ++g) {
    const int tt = tbase + g * 8 + tl;
    __syncthreads();
    if (j < 33) {
      float val;
      if (j == 0) val = (float)tt / (float)(n - 1);
      else {
        const float w = (6.283185307179586f * (float)tt) / (float)n;
        const int i = (j - 1) & 15;
        const float f = 1e-4f + (float)i * ((15.0f - 1e-4f) / 15.0f);
        val = (j <= 16) ? cosf(f * w) : -sinf(f * w);
      }
      zs[tl * 36 + j] = val;
    }
    __syncthreads();
    float a = b1j;
#pragma unroll
    for (int i = 0; i < 33; ++i) a += zs[tl * 36 + i] * w1s[i * 64 + j];
    hs[tl * 64 + j] = sinf(frj * a);
    __syncthreads();
    float a2 = b2j;
#pragma unroll
    for (int i = 0; i < 64; ++i) a2 += hs[tl * 64 + i] * w2s[i * 64 + j];
    dst[(size_t)tt * 64 + j] = sinf(frj * a2);
  }
}

DI void phase0(const Params& p, unsigned char* smem) {
  float* sm = (float*)smem;
  for (int it = blockIdx.x; it < 2533; it += gridDim.x) {
    if (it < 1664) {
      int l = it / 832, rem = it % 832; int kt = rem / 52, nt = rem % 52;
      p0_transpose(p.w_in + (size_t)l * 1024 * INW, 1024, INW, (u16*)(p.ws + OFF_WINT) + (size_t)l * INW * 1024, kt * 64, nt * 64, sm);
    } else if (it < 2176) {
      int i2 = it - 1664; int l = i2 >> 8, rem = i2 & 255; int kt = rem >> 4, nt = rem & 15;
      p0_transpose(p.w_out + (size_t)l * 1024 * 1024, 1024, 1024, (u16*)(p.ws + OFF_WOUTT) + (size_t)l * 1024 * 1024, kt * 64, nt * 64, sm);
    } else if (it < 2272) {
      int i2 = it - 2176; p0_adaln(p, i2 / 48, i2 % 48, sm);
    } else if (it < 2528) {
      p0_mlp(p, (it - 2272) * 64, S, (float*)(p.ws + OFF_HDN2), sm);
    } else if (it < 2532) {
      p0_mlp(p, (it - 2528) * 64, NC, (float*)(p.ws + OFF_HDN2C), sm);
    } else {
      float2* tab = (float2*)(p.ws + OFF_ROPE);
      for (int e = threadIdx.x; e < 5120; e += 512) {
        int pos = e >> 4, pi = e & 15; float pv = (float)(pos < 256 ? pos : pos - 256);
        float inv = powf(10000.0f, -(float)pi / 16.0f);
        float ang = pv * inv; float sn, cs; sincosf(ang, &sn, &cs);
        tab[e] = make_float2(cs, sn);
      }
    }
  }
}

DI void modnorm_rows(const Params& p, int layer, int item) {
  const int w = threadIdx.x >> 6, lane = threadIdx.x & 63;
  const float* g = p.norm_g + layer * 1024;
  const float* src[2]; const float* md[2]; int rowi[2];
#pragma unroll
  for (int j = 0; j < 2; ++j) {
    const int row = item * 16 + j * 8 + w; int v;
    if (row < MLAT) { src[j] = (layer == 0 ? p.x : (const float*)p.out) + (size_t)row * 1024; v = row >> 14; }
    else { src[j] = (layer == 0 ? p.ctx : (const float*)(p.ws + OFF_XC1)) + (size_t)(row - MLAT) * 1024; v = 2; }
    md[j] = (const float*)(p.ws + OFF_MOD) + (layer * 3 + v) * 3072; rowi[j] = row;
  }
  float4 xv[2][4]; float ss[2] = {0.f, 0.f};
#pragma unroll
  for (int j = 0; j < 2; ++j)
#pragma unroll
    for (int i = 0; i < 4; ++i) xv[j][i] = *(const float4*)(src[j] + i * 256 + lane * 4);
#pragma unroll
  for (int j = 0; j < 2; ++j) {
#pragma unroll
    for (int i = 0; i < 4; ++i) ss[j] += xv[j][i].x * xv[j][i].x + xv[j][i].y * xv[j][i].y + xv[j][i].z * xv[j][i].z + xv[j][i].w * xv[j][i].w;
    ss[j] = wave_sum(ss[j]);
  }
#pragma unroll
  for (int j = 0; j < 2; ++j) {
    const float rstd = rsqrtf(ss[j] * (1.f / 1024.f) + EPSF);
    u16* h = (u16*)(p.ws + OFF_H) + (size_t)rowi[j] * 1024;
#pragma unroll
    for (int i = 0; i < 4; ++i) {
      const int col = i * 256 + lane * 4;
      const float4 g4 = *(const float4*)(g + col), sh = *(const float4*)(md[j] + col), sc = *(const float4*)(md[j] + 1024 + col);
      float y0 = xv[j][i].x * rstd * g4.x * (1.f + sc.x) + sh.x, y1 = xv[j][i].y * rstd * g4.y * (1.f + sc.y) + sh.y;
      float y2 = xv[j][i].z * rstd * g4.z * (1.f + sc.z) + sh.z, y3 = xv[j][i].w * rstd * g4.w * (1.f + sc.w) + sh.w;
      *(uint2*)(h + col) = make_uint2(pack2(y0, y1), pack2(y2, y3));
    }
  }
}

DI void filt_item(const Params& p, int tb, int cg) {
  const int t = threadIdx.x, lane = t & 63, w = t >> 6, r = lane & 31, h = lane >> 5;
  const bool isctx = (tb == 64);
  const int n = isctx ? NC : S;
  const float* hd = isctx ? (const float*)(p.ws + OFF_HDN2C) : (const float*)(p.ws + OFF_HDN2);
  float* dst = isctx ? (float*)(p.ws + OFF_FILTTC) : (float*)(p.ws + OFF_FILTT);
  const int t0 = (isctx ? 0 : tb * 256) + w * 32;
  float bv[32];
  const float* hr = hd + (size_t)(t0 + r) * 64 + h * 32;
#pragma unroll
  for (int i = 0; i < 8; ++i) { float4 q4 = *(const float4*)(hr + i * 4); bv[4 * i] = q4.x; bv[4 * i + 1] = q4.y; bv[4 * i + 2] = q4.z; bv[4 * i + 3] = q4.w; }
  const float tl2 = -((float)(t0 + r) / (float)(n - 1)) * LOG2E;
  const float da = -3.0701134573253945f, db = -15.350567286626972f;
#pragma nounroll
  for (int ct = 0; ct < 16; ++ct) {
    const int col0 = cg * 512 + ct * 32;
    const float* wp = p.w3 + (size_t)(h * 32) * 2048 + col0 + r;
    f32x16 acc;
#pragma unroll
    for (int i = 0; i < 16; ++i) acc[i] = 0.f;
#pragma unroll
    for (int s = 0; s < 32; ++s) acc = __builtin_amdgcn_mfma_f32_32x32x2f32(wp[(size_t)s * 2048], bv[s], acc, 0, 0, 0);
#pragma unroll
    for (int reg = 0; reg < 16; ++reg) {
      const int col = col0 + crow(reg, h); const int ch = col & 511;
      const float delta = da + (db - da) * ((float)ch / 511.0f);
      const float dec = __builtin_amdgcn_exp2f(tl2 * fabsf(delta));
      if (isctx) dst[(size_t)col * n + t0 + r] = acc[reg] * dec;
      else ((u16*)dst)[(size_t)col * n + t0 + r] = f2bf(acc[reg] * dec);
    }
  }
}

DI void phase1(const Params& p, unsigned char* smem) {
  for (int it = blockIdx.x; it < 256; it += gridDim.x) filt_item(p, it >> 2, it & 3);
  for (int it = blockIdx.x; it < 2080 + 4; it += gridDim.x) {
    if (it < 2080) modnorm_rows(p, 0, it); else filt_item(p, 64, it - 2080);
  }
}

DI float head_rstd(const f32x16& a0, const f32x16& a1) {
  float ss = 0.f;
#pragma unroll
  for (int i = 0; i < 16; ++i) ss += a0[i] * a0[i] + a1[i] * a1[i];
  ss += __shfl_xor(ss, 32);
  return rsqrtf(ss * (1.f / 64.f) + EPSF);
}
DI void store_qk(const f32x16& a0, const f32x16& a1, const float* gn, bool rope, int tpos, float scale, u16* dst, const float2* tab, int h) {
  const float rstd = head_rstd(a0, a1) ;
#pragma unroll
  for (int ni = 0; ni < 2; ++ni) {
#pragma unroll
    for (int q = 0; q < 4; ++q) {
      const int f0 = ni * 32 + 8 * q + 4 * h;
      const float4 g4 = *(const float4*)(gn + f0);
      float v0 = (ni == 0 ? a0[4 * q] : a1[4 * q]) * rstd * g4.x;
      float v1 = (ni == 0 ? a0[4 * q + 1] : a1[4 * q + 1]) * rstd * g4.y;
      float v2 = (ni == 0 ? a0[4 * q + 2] : a1[4 * q + 2]) * rstd * g4.z;
      float v3 = (ni == 0 ? a0[4 * q + 3] : a1[4 * q + 3]) * rstd * g4.w;
      if (rope) {
        const int pa = 4 * q + 2 * h;
        const float2* tr = (ni == 0) ? (tab + (tpos >> 6) * 16) : (tab + (256 + (tpos & 63)) * 16);
        const float2 ca = tr[pa], cb = tr[pa + 1];
        float r0 = v0 * ca.x - v1 * ca.y, r1 = v0 * ca.y + v1 * ca.x;
        float r2 = v2 * cb.x - v3 * cb.y, r3 = v2 * cb.y + v3 * cb.x;
        v0 = r0; v1 = r1; v2 = r2; v3 = r3;
      }
      *(uint2*)(dst + f0) = make_uint2(pack2(v0 * scale, v1 * scale), pack2(v2 * scale, v3 * scale));
    }
  }
}
DI void store_T_bf16(const f32x16& a0, const f32x16& a1, u16* dst, size_t pitch, int h, bool dosilu) {
#pragma unroll
  for (int ni = 0; ni < 2; ++ni)
#pragma unroll
    for (int reg = 0; reg < 16; ++reg) {
      float v = ni == 0 ? a0[reg] : a1[reg];
      if (dosilu) v = siluf(v);
      dst[(size_t)(ni * 32 + crow(reg, h)) * pitch] = f2bf(v);
    }
}
DI void store_T_f32(const f32x16& a0, const f32x16& a1, float* dst, size_t pitch, int h, bool dosilu) {
#pragma unroll
  for (int ni = 0; ni < 2; ++ni)
#pragma unroll
    for (int reg = 0; reg < 16; ++reg) {
      float v = ni == 0 ? a0[reg] : a1[reg];
      if (dosilu) v = siluf(v);
      dst[(size_t)(ni * 32 + crow(reg, h)) * pitch] = v;
    }
}
DI void store_silu_row(const f32x16& a0, const f32x16& a1, u16* dst, int h) {
#pragma unroll
  for (int ni = 0; ni < 2; ++ni)
#pragma unroll
    for (int q = 0; q < 4; ++q) {
      const int f0 = ni * 32 + 8 * q + 4 * h;
      float v0 = siluf(ni == 0 ? a0[4 * q] : a1[4 * q]), v1 = siluf(ni == 0 ? a0[4 * q + 1] : a1[4 * q + 1]);
      float v2 = siluf(ni == 0 ? a0[4 * q + 2] : a1[4 * q + 2]), v3 = siluf(ni == 0 ? a0[4 * q + 3] : a1[4 * q + 3]);
      *(uint2*)(dst + f0) = make_uint2(pack2(v0, v1), pack2(v2, v3));
    }
}

template <int EPI>
DI void gemm_epilogue(const Params& p, f32x16 (&acc)[2][4], int nb, int mb, int r, int h) {
  unsigned char* ws = p.ws;
  const float2* tab = (const float2*)(ws + OFF_ROPE);
  const bool isctx = mb >= MLAT;
#pragma unroll
  for (int mi = 0; mi < 4; ++mi) {
    const int mrow = mb + mi * 32 + r;
    const int b = isctx ? ((mrow - MLAT) >> 8) : (mrow >> 14);
    const int tpos = isctx ? ((mrow - MLAT) & 255) : (mrow & (S - 1));
    const int kpos = isctx ? tpos : NC + tpos;
    const f32x16& a0 = acc[0][mi];
    const f32x16& a1 = acc[1][mi];
    if (EPI == 0) {
      if (nb < 512) {
        const int head = nb >> 6;
        u16* dst = isctx ? (u16*)(ws + OFF_QC) + ((size_t)(b * 8 + head) * NC + tpos) * 64 : (u16*)(ws + OFF_Q) + ((size_t)(b * 8 + head) * S + tpos) * 64;
        store_qk(a0, a1, p.gq, !isctx, tpos, QSCALE, dst, tab, h);
      } else if (nb < 640) {
        const int kvh = (nb - 512) >> 6;
        store_qk(a0, a1, p.gk, !isctx, tpos, 1.f, (u16*)(ws + OFF_K) + ((size_t)(b * 2 + kvh) * KTOT + kpos) * 64, tab, h);
      } else if (nb < 768) {
        const int kvh = (nb - 640) >> 6;
        store_T_bf16(a0, a1, (u16*)(ws + OFF_VT) + (size_t)(b * 2 + kvh) * 64 * KTOT + kpos, KTOT, h, false);
      } else if (nb < 2304) {
        const int ch = nb - 768;
        if (isctx) store_T_f32(a0, a1, (float*)(ws + OFF_UTC) + (size_t)(b * 1536 + ch) * NC + tpos, NC, h, false);
        else store_T_bf16(a0, a1, (u16*)(ws + OFF_UT) + (size_t)(b * 1536 + ch) * S + tpos, S, h, false);
      } else if (nb < 2816) {
        store_silu_row(a0, a1, (u16*)(ws + OFF_Y) + (size_t)mrow * 1024 + (nb - 2304), h);
      } else {
        const int ch = nb - 2816;
        if (isctx) store_T_f32(a0, a1, (float*)(ws + OFF_HGTC) + (size_t)(b * 512 + ch) * NC + tpos, NC, h, true);
        else store_T_bf16(a0, a1, (u16*)(ws + OFF_HGT) + (size_t)(b * 512 + ch) * S + tpos, S, h, true);
      }
    } else if (EPI == 1) {
      if (nb < 512) {
        if (!isctx) store_qk(a0, a1, p.wqn, true, tpos, QSCALE, (u16*)(ws + OFF_QW) + ((size_t)(b * 8 + (nb >> 6)) * S + tpos) * 64, tab, h);
      } else if (nb < 640) {
        const int kvh = (nb - 512) >> 6;
        store_qk(a0, a1, p.wkn, !isctx, tpos, 1.f, (u16*)(ws + OFF_KW) + ((size_t)(b * 2 + kvh) * KTOT + kpos) * 64, tab, h);
      } else if (nb < 768) {
        const int kvh = (nb - 640) >> 6;
        store_T_bf16(a0, a1, (u16*)(ws + OFF_VWT) + (size_t)(b * 2 + kvh) * 64 * KTOT + kpos, KTOT, h, false);
      } else if (nb < 1280) {
        if (!isctx) store_qk(a0, a1, p.nqn, false, tpos, QSCALE, (u16*)(ws + OFF_QN) + ((size_t)(b * 8 + ((nb - 768) >> 6)) * S + tpos) * 64, tab, h);
      } else if (nb < 1792) {
        const int head = (nb - 1280) >> 6;
        store_qk(a0, a1, p.nkn, false, tpos, 1.f, (u16*)(ws + OFF_KN) + ((size_t)(b * 8 + head) * KTOT + kpos) * 64, tab, h);
      } else if (nb < 2304) {
        const int head = (nb - 1792) >> 6;
        store_T_bf16(a0, a1, (u16*)(ws + OFF_VNT) + (size_t)(b * 8 + head) * 64 * KTOT + kpos, KTOT, h, false);
      } else {
        if (!isctx) store_silu_row(a0, a1, (u16*)(ws + OFF_Y) + (size_t)mrow * 1024 + (nb - 2304), h);
      }
    } else {
      const int layer = EPI - 2;
      const float* gate = (const float*)(ws + OFF_MOD) + (layer * 3 + (isctx ? 2 : b)) * 3072 + 2048;
      const float* src; float* dst;
      if (isctx) { src = p.ctx + (size_t)(mrow - MLAT) * 1024; dst = (float*)(ws + OFF_XC1) + (size_t)(mrow - MLAT) * 1024; }
      else { src = (layer == 0 ? p.x : (const float*)p.out) + (size_t)mrow * 1024; dst = p.out + (size_t)mrow * 1024; }
#pragma unroll
      for (int ni = 0; ni < 2; ++ni)
#pragma unroll
        for (int q = 0; q < 4; ++q) {
          const int n = nb + ni * 32 + 8 * q + 4 * h;
          const float4 g4 = *(const float4*)(gate + n);
          const float4 x4 = *(const float4*)(src + n);
          float4 o;
          o.x = x4.x + g4.x * (ni == 0 ? a0[4 * q] : a1[4 * q]);
          o.y = x4.y + g4.y * (ni == 0 ? a0[4 * q + 1] : a1[4 * q + 1]);
          o.z = x4.z + g4.z * (ni == 0 ? a0[4 * q + 2] : a1[4 * q + 2]);
          o.w = x4.w + g4.w * (ni == 0 ? a0[4 * q + 3] : a1[4 * q + 3]);
          *(float4*)(dst + n) = o;
        }
    }
  }
}

template <int EPI>
DI void gemm_tile(const Params& p, const u16* A, const u16* WT, int m0, int n0, unsigned char* smem, uint4& gw0, uint4& gw1, uint4& gw2, uint4& gw3, uint4& ga0, uint4& ga1, uint4& ga2, uint4& ga3, bool pre, int nm0, int nn0, bool has_next) {
  const int t = threadIdx.x, lane = t & 63, w = t >> 6, r = lane & 31, h = lane >> 5;
  const int wn = w & 3, wm = w >> 2;
  constexpr int ST = 256 * 72;
  u16* sW = (u16*)smem;
  u16* sA = sW + 2 * ST;
  f32x16 acc[2][4];
#pragma unroll
  for (int i = 0; i < 2; ++i)
#pragma unroll
    for (int j = 0; j < 4; ++j)
#pragma unroll
      for (int k = 0; k < 16; ++k) acc[i][j][k] = 0.f;
  const u16* gW = WT + (size_t)(n0 + (t >> 3)) * 1024 + (t & 7) * 8;
  const u16* gA = A + (size_t)(m0 + (t >> 3)) * 1024 + (t & 7) * 8;
  const int lo = (t >> 3) * 72 + (t & 7) * 8;
#define GLOADP(PW, PA, k0) { gw0 = *(const uint4*)((PW) + (k0)); gw1 = *(const uint4*)((PW) + 64 * 1024 + (k0)); gw2 = *(const uint4*)((PW) + 128 * 1024 + (k0)); gw3 = *(const uint4*)((PW) + 192 * 1024 + (k0)); \
                             ga0 = *(const uint4*)((PA) + (k0)); ga1 = *(const uint4*)((PA) + 64 * 1024 + (k0)); ga2 = *(const uint4*)((PA) + 128 * 1024 + (k0)); ga3 = *(const uint4*)((PA) + 192 * 1024 + (k0)); }
#define GLOAD(k0) GLOADP(gW, gA, k0)
#define LSTORE(nx) { *(uint4*)(sW + (nx) + lo) = gw0; *(uint4*)(sW + (nx) + lo + 64 * 72) = gw1; *(uint4*)(sW + (nx) + lo + 128 * 72) = gw2; *(uint4*)(sW + (nx) + lo + 192 * 72) = gw3; \
                     *(uint4*)(sA + (nx) + lo) = ga0; *(uint4*)(sA + (nx) + lo + 64 * 72) = ga1; *(uint4*)(sA + (nx) + lo + 128 * 72) = ga2; *(uint4*)(sA + (nx) + lo + 192 * 72) = ga3; }
  const int rot = (blockIdx.x >> 3) & 15;
  if (!pre) GLOAD(rot * 64)
  LSTORE(0)
  GLOAD(((1 + rot) & 15) * 64)
#pragma nounroll
  for (int kt = 0; kt < 16; ++kt) {
    const int cur = kt & 1;
    __syncthreads();
    if (kt < 15) {
      LSTORE((cur ^ 1) * ST)
      if (kt < 14) GLOAD(((kt + 2 + rot) & 15) * 64)
    }
    const u16* cw = sW + cur * ST + (wn * 64 + r) * 72 + h * 8;
    const u16* ca = sA + cur * ST + (wm * 128 + r) * 72 + h * 8;
#pragma unroll
    for (int ks = 0; ks < 4; ++ks) {
      bf16x8 af0 = *(const bf16x8*)(cw + ks * 16), af1 = *(const bf16x8*)(cw + 32 * 72 + ks * 16);
      bf16x8 b0 = *(const bf16x8*)(ca + ks * 16), b1 = *(const bf16x8*)(ca + 32 * 72 + ks * 16);
      bf16x8 b2 = *(const bf16x8*)(ca + 64 * 72 + ks * 16), b3 = *(const bf16x8*)(ca + 96 * 72 + ks * 16);
      acc[0][0] = MFMA(af0, b0, acc[0][0]); acc[0][1] = MFMA(af0, b1, acc[0][1]); acc[0][2] = MFMA(af0, b2, acc[0][2]); acc[0][3] = MFMA(af0, b3, acc[0][3]);
      acc[1][0] = MFMA(af1, b0, acc[1][0]); acc[1][1] = MFMA(af1, b1, acc[1][1]); acc[1][2] = MFMA(af1, b2, acc[1][2]); acc[1][3] = MFMA(af1, b3, acc[1][3]);
    }
  }
  __syncthreads();
  if (has_next) {
    const u16* nW = WT + (size_t)(nn0 + (t >> 3)) * 1024 + (t & 7) * 8;
    const u16* nA = A + (size_t)(nm0 + (t >> 3)) * 1024 + (t & 7) * 8;
    GLOADP(nW, nA, rot * 64)
  }
#undef GLOAD
#undef GLOADP
#undef LSTORE
  gemm_epilogue<EPI>(p, acc, n0 + wn * 64, m0 + wm * 128, r, h);
}

template <int EPI>
DI void gemm_phase(const Params& p, const u16* A, const u16* WT, int mtiles, int ntiles, int srm, unsigned char* smem) {
  const int bpg = gridDim.x >> 3;
  const int xg = blockIdx.x & 7, li = blockIdx.x >> 3;
  const int nsr = (mtiles + srm - 1) / srm;
  const int per_sr = srm * ntiles;
  const int total = nsr * per_sr;
  auto tile_at = [&](int j, int& mt, int& nt) -> bool {
    const int lin = (j * 8 + xg) * bpg + li;
    if (lin >= total || li >= bpg) return false;
    const int sr = lin / per_sr, rem = lin % per_sr;
    nt = rem / srm; mt = sr * srm + rem % srm;
    return mt < mtiles;
  };
  int j = 0, mt = 0, nt = 0; bool have = false;
  for (; j * 8 * bpg < total; ++j) if (tile_at(j, mt, nt)) { have = true; break; }
  uint4 gw0, gw1, gw2, gw3, ga0, ga1, ga2, ga3; bool pre = false;
#pragma nounroll
  while (have) {
    int j2 = j + 1, mt2 = 0, nt2 = 0; bool have2 = false;
    for (; j2 * 8 * bpg < total; ++j2) if (tile_at(j2, mt2, nt2)) { have2 = true; break; }
    gemm_tile<EPI>(p, A, WT, mt * 256, nt * 256, smem, gw0, gw1, gw2, gw3, ga0, ga1, ga2, ga3, pre, mt2 * 256, nt2 * 256, have2);
    pre = have2; have = have2; j = j2; mt = mt2; nt = nt2;
  }
}

template <int MODE>
DI void attn_unit(const u16* Qw, const u16* Kb, const u16* VTb, int nt0, int seg1_lo, int nt1,
                  int tqw  , int qr  , float sinkl2, const float* rpbs,
                  u16* yrow  , unsigned char* smem) {
  const int t = threadIdx.x, lane = t & 63, r = lane & 31, h = lane >> 5;
  constexpr int STG = 2 * 64 * 72;
  u16* sKV = (u16*)smem;
  const int ntiles = nt0 + nt1;
  const int lrow = t >> 3, lc = t & 7;
  const int kofs = lrow * 72 + lc * 8;
  const int vofs0 = 64 * 72 + lrow * 72 + 16 * (lc >> 1) + 4 * (lc & 1), vofs1 = vofs0 + 8;
  uint4 rk, rv;
  const int toff = (MODE == 0) ? (((blockIdx.x >> 3) * nt0) >> 5) : 0;
#define KEY0(i) ((MODE == 0) ? ((((i) + toff) >= nt0 ? (i) + toff - nt0 : (i) + toff) * 64) : (((i) < nt0) ? (i) * 64 : seg1_lo + ((i) - nt0) * 64))
#define TLOAD(i) { const int k0_ = KEY0(i); rk = *(const uint4*)(Kb + (size_t)(k0_ + lrow) * 64 + lc * 8); rv = *(const uint4*)(VTb + (size_t)lrow * KTOT + k0_ + lc * 8); }
#define TSTORE(st) { u16* d_ = sKV + (st) * STG; *(uint4*)(d_ + kofs) = rk; *(uint2*)(d_ + vofs0) = make_uint2(rv.x, rv.y); *(uint2*)(d_ + vofs1) = make_uint2(rv.z, rv.w); }
  TLOAD(0)
  bf16x8 qf[4];
#pragma unroll
  for (int ks = 0; ks < 4; ++ks) qf[ks] = *(const bf16x8*)(Qw + r * 64 + ks * 16 + h * 8);
  TSTORE(0)
  if (ntiles > 1) { TLOAD(1) TSTORE(1) }
  { u16* d_ = sKV + 3 * STG; *(uint2*)(d_ + vofs0) = make_uint2(0u, 0u); *(uint2*)(d_ + vofs1) = make_uint2(0u, 0u); }
  __syncthreads();
  f32x16 o0, o1, sc0, sc1, negm;
#pragma unroll
  for (int i = 0; i < 16; ++i) { o0[i] = 0.f; o1[i] = 0.f; sc0[i] = 0.f; sc1[i] = 0.f; negm[i] = 0.f; }
  {
    const u16* ck = sKV + r * 72 + h * 8;
#pragma unroll
    for (int ks = 0; ks < 4; ++ks) {
      bf16x8 k0f = *(const bf16x8*)(ck + ks * 16), k1f = *(const bf16x8*)(ck + 32 * 72 + ks * 16);
      sc0 = MFMA(k0f, qf[ks], sc0); sc1 = MFMA(k1f, qf[ks], sc1);
    }
  }
  bf16x8 pp[4];
#pragma unroll
  for (int i = 0; i < 4; ++i) pp[i] = bf16x8{0, 0, 0, 0, 0, 0, 0, 0};
  float m = -1e30f, lsum = 0.f;
  float mref_c = 0.f;
  float mref_n = 0.f;
  const int tq = tqw + r;
  const int qc = tq & 63;
  int c0 = qc - 8; c0 = c0 < 0 ? 0 : (c0 > 48 ? 48 : c0);
  int r0w = qr - 4; r0w = r0w < 0 ? 0 : (r0w > 248 ? 248 : r0w);
  bool pend = false; float apend = 1.f;
  uint4 rk2, rv2;
#define TLOADR(i, RK, RV) { const int k0_ = KEY0(i); RK = *(const uint4*)(Kb + (size_t)(k0_ + lrow) * 64 + lc * 8); RV = *(const uint4*)(VTb + (size_t)lrow * KTOT + k0_ + lc * 8); }
#define TSTORER(st, RK, RV) { u16* d_ = sKV + (st) * STG; *(uint4*)(d_ + kofs) = RK; *(uint2*)(d_ + vofs0) = make_uint2(RV.x, RV.y); *(uint2*)(d_ + vofs1) = make_uint2(RV.z, RV.w); }
  constexpr bool DEEP = (MODE == 0);
  { const int i2 = (2 < ntiles) ? 2 : ntiles - 1; TLOADR(i2, rk, rv) }
  if (DEEP) { const int i3 = (3 < ntiles) ? 3 : ntiles - 1; TLOADR(i3, rk2, rv2) }
  auto step = [&](const int i, uint4& lk, uint4& lv) __attribute__((always_inline)) {
    TSTORER((i + 2) & 3, lk, lv)
    if (pend) {
#pragma unroll
      for (int j = 0; j < 16; ++j) { o0[j] *= apend; o1[j] *= apend; if (MODE == 0) negm[j] = -m; }
      if (MODE == 0) mref_n = m;
    }
    { const int ahead = DEEP ? i + 4 : i + 3; const int inx = (ahead < ntiles) ? ahead : ntiles - 1; TLOADR(inx, lk, lv) }
    f32x16 sn0, sn1;
    {
      const u16* ck = sKV + ((i + 1) & 3) * STG + r * 72 + h * 8;
      {
        bf16x8 k0f = *(const bf16x8*)(ck), k1f = *(const bf16x8*)(ck + 32 * 72);
        sn0 = MFMA(k0f, qf[0], negm); sn1 = MFMA(k1f, qf[0], negm);
      }
#pragma unroll
      for (int ks = 1; ks < 4; ++ks) {
        bf16x8 k0f = *(const bf16x8*)(ck + ks * 16), k1f = *(const bf16x8*)(ck + 32 * 72 + ks * 16);
        sn0 = MFMA(k0f, qf[ks], sn0); sn1 = MFMA(k1f, qf[ks], sn1);
      }
    }
    const float mref_next = mref_n;
    const bool seg1 = (i >= nt0);
    const int tk0 = KEY0(i) - NC;
    if (MODE == 1 && seg1) {
#pragma unroll
      for (int j = 0; j < 16; ++j) {
        const int tk = tk0 + crow(j, h);
        int d0 = tq - tk; d0 = d0 < 0 ? -d0 : d0;
        int d1 = tq - (tk + 32); d1 = d1 < 0 ? -d1 : d1;
        if (d0 > 128) sc0[j] = -1e30f;
        if (d1 > 128) sc1[j] = -1e30f;
      }
    }
    if (MODE == 2 && seg1) {
      const int kr = tk0 >> 6;
      const bool rowok = (kr >= r0w) && (kr < r0w + 8);
      int krel = kr - qr + 7; krel = krel < 0 ? 0 : (krel > 14 ? 14 : krel);
      const float* br = rpbs + krel * 31 + 15 - qc;
#pragma unroll
      for (int j = 0; j < 16; ++j) {
        const int kc0 = crow(j, h), kc1 = kc0 + 32;
        const bool v0 = rowok && (kc0 >= c0) && (kc0 < c0 + 16);
        const bool v1 = rowok && (kc1 >= c0) && (kc1 < c0 + 16);
        sc0[j] = v0 ? sc0[j] + br[v0 ? kc0 : qc] : -1e30f;
        sc1[j] = v1 ? sc1[j] + br[v1 ? kc1 : qc] : -1e30f;
      }
    }
    float mt = fmaxf(sc0[0], sc1[0]);
#pragma unroll
    for (int j = 1; j < 16; ++j) mt = fmaxf(fmaxf(mt, sc0[j]), sc1[j]);
    mt = fmaxf(mt, __shfl_xor(mt, 32));
    mt += mref_c;
    const bool resc = __builtin_amdgcn_ballot_w64(mt > m + 8.0f) != 0;
    float alpha = 1.f;
    if (resc) { const float mnew = fmaxf(m, mt); alpha = __builtin_amdgcn_exp2f(m - mnew); m = mnew; lsum *= alpha; }
    if (__builtin_amdgcn_ballot_w64(mref_c != m) != 0) {
      const float dlt = mref_c - m;
#pragma unroll
      for (int j = 0; j < 16; ++j) { sc0[j] += dlt; sc1[j] += dlt; }
    }
    float ps0 = 0.f, ps1 = 0.f;
#pragma unroll
    for (int j = 0; j < 16; ++j) { sc0[j] = __builtin_amdgcn_exp2f(sc0[j]); sc1[j] = __builtin_amdgcn_exp2f(sc1[j]); ps0 += sc0[j]; ps1 += sc1[j]; }
    lsum += ps0 + ps1;
    bf16x8 pc[4];
#pragma unroll
    for (int ss = 0; ss < 2; ++ss) {
      pc[ss] = __builtin_bit_cast(bf16x8, make_uint4(pack2a(sc0[8 * ss + 0], sc0[8 * ss + 1]), pack2a(sc0[8 * ss + 2], sc0[8 * ss + 3]), pack2a(sc0[8 * ss + 4], sc0[8 * ss + 5]), pack2a(sc0[8 * ss + 6], sc0[8 * ss + 7])));
      pc[2 + ss] = __builtin_bit_cast(bf16x8, make_uint4(pack2a(sc1[8 * ss + 0], sc1[8 * ss + 1]), pack2a(sc1[8 * ss + 2], sc1[8 * ss + 3]), pack2a(sc1[8 * ss + 4], sc1[8 * ss + 5]), pack2a(sc1[8 * ss + 6], sc1[8 * ss + 7])));
    }
    {
      const u16* cv = sKV + ((i + 3) & 3) * STG + 64 * 72 + r * 72 + h * 8;
#pragma unroll
      for (int ks = 0; ks < 4; ++ks) {
        bf16x8 v0f = *(const bf16x8*)(cv + ks * 16), v1f = *(const bf16x8*)(cv + 32 * 72 + ks * 16);
        o0 = MFMA(v0f, pp[ks], o0); o1 = MFMA(v1f, pp[ks], o1);
      }
    }
    pend = resc; apend = alpha;
    __syncthreads();
    sc0 = sn0; sc1 = sn1; mref_c = mref_next;
#pragma unroll
    for (int ks = 0; ks < 4; ++ks) pp[ks] = pc[ks];
    };
  if (DEEP) {
#pragma nounroll
    for (int i = 0; i < ntiles; i += 2) { step(i, rk, rv); if (i + 1 < ntiles) step(i + 1, rk2, rv2); }
  } else {
#pragma nounroll
    for (int i = 0; i < ntiles; ++i) step(i, rk, rv);
  }
#undef TLOADR
#undef TSTORER
  if (pend) {
#pragma unroll
    for (int j = 0; j < 16; ++j) { o0[j] *= apend; o1[j] *= apend; }
  }
  {
    const u16* cv = sKV + ((ntiles + 3) & 3) * STG + 64 * 72 + r * 72 + h * 8;
#pragma unroll
    for (int ks = 0; ks < 4; ++ks) {
      bf16x8 v0f = *(const bf16x8*)(cv + ks * 16), v1f = *(const bf16x8*)(cv + 32 * 72 + ks * 16);
      o0 = MFMA(v0f, pp[ks], o0); o1 = MFMA(v1f, pp[ks], o1);
    }
  }
#undef KEY0
#undef TLOAD
#undef TSTORE
  float l = lsum + __shfl_xor(lsum, 32);
  if (MODE == 1) l += __builtin_amdgcn_exp2f(sinkl2 - m);
  const float inv = 1.f / l;
#pragma unroll
  for (int di = 0; di < 2; ++di)
#pragma unroll
    for (int q = 0; q < 4; ++q) {
      const int d0 = di * 32 + 8 * q + 4 * h;
      uint2 g = *(const uint2*)(yrow + d0);
      float v0 = (di == 0 ? o0[4 * q] : o1[4 * q]) * inv * bf2f((u16)(g.x & 0xffff));
      float v1 = (di == 0 ? o0[4 * q + 1] : o1[4 * q + 1]) * inv * bf2f((u16)(g.x >> 16));
      float v2 = (di == 0 ? o0[4 * q + 2] : o1[4 * q + 2]) * inv * bf2f((u16)(g.y & 0xffff));
      float v3 = (di == 0 ? o0[4 * q + 3] : o1[4 * q + 3]) * inv * bf2f((u16)(g.y >> 16));
      *(uint2*)(yrow + d0) = make_uint2(pack2(v0, v1), pack2(v2, v3));
    }
}

typedef float v2f __attribute__((ext_vector_type(2)));
DI v2f cmulv(v2f a, v2f cs, v2f ncs) { return a.xx * cs + a.yy * ncs; }
DI void fft_pass_fwd(float2* buf_, int lm) {
  v2f* buf = (v2f*)buf_;
  const int m = 1 << lm, hm = m >> 1;
  const float rinv = 1.0f / (float)(2 * m);
#pragma unroll 4
  for (int q = 0; q < 8; ++q) {
    const int j = threadIdx.x + 512 * q;
    const int blk = j >> (lm - 1), idx = j & (hm - 1);
    const int i0 = (blk << (lm + 1)) + idx;
    v2f e0 = buf[i0], e1 = buf[i0 + hm], e2 = buf[i0 + m], e3 = buf[i0 + m + hm];
    const float fr = (float)idx * rinv;
    const float c = __builtin_amdgcn_cosf(fr), s = -__builtin_amdgcn_sinf(fr);
    const v2f cs = {c, s}, ncs = {-s, c};
    const float c2 = c * c - s * s, s2 = 2.f * c * s;
    const v2f cs2 = {c2, s2}, ncs2 = {-s2, c2};
    v2f a0 = e0 + e2;
    v2f a2 = cmulv(e0 - e2, cs, ncs);
    v2f a1 = e1 + e3;
    v2f t13 = cmulv(e1 - e3, cs, ncs);
    v2f a3 = {t13.y, -t13.x};
    buf[i0] = a0 + a1;
    buf[i0 + hm] = cmulv(a0 - a1, cs2, ncs2);
    buf[i0 + m] = a2 + a3;
    buf[i0 + m + hm] = cmulv(a2 - a3, cs2, ncs2);
  }
  __syncthreads();
}
DI void fft_pass_inv(float2* buf_, int lm) {
  v2f* buf = (v2f*)buf_;
  const int m = 1 << lm, hm = m >> 1;
  const float rinv = 1.0f / (float)(2 * m);
#pragma unroll 4
  for (int q = 0; q < 8; ++q) {
    const int j = threadIdx.x + 512 * q;
    const int blk = j >> (lm - 1), idx = j & (hm - 1);
    const int i0 = (blk << (lm + 1)) + idx;
    v2f b0 = buf[i0], b1 = buf[i0 + hm], b2 = buf[i0 + m], b3 = buf[i0 + m + hm];
    const float fr = (float)idx * rinv;
    const float c = __builtin_amdgcn_cosf(fr), s = __builtin_amdgcn_sinf(fr);
    const v2f cs = {c, s}, ncs = {-s, c};
    const float c2 = c * c - s * s, s2 = 2.f * c * s;
    const v2f cs2 = {c2, s2}, ncs2 = {-s2, c2};
    v2f t1 = cmulv(b1, cs2, ncs2), t3 = cmulv(b3, cs2, ncs2);
    v2f a0 = b0 + t1, a1 = b0 - t1, a2 = b2 + t3, a3 = b2 - t3;
    v2f u2 = cmulv(a2, cs, ncs);
    v2f u3r = cmulv(a3, cs, ncs);
    v2f u3 = {-u3r.y, u3r.x};
    buf[i0] = a0 + u2;
    buf[i0 + m] = a0 - u2;
    buf[i0 + hm] = a1 + u3;
    buf[i0 + m + hm] = a1 - u3;
  }
  __syncthreads();
}
DI void fft_fwd(float2* buf) {
#pragma nounroll
  for (int lm = 13; lm >= 3; lm -= 2) fft_pass_fwd(buf, lm);
}
DI void fft_inv(float2* buf) {
#pragma nounroll
  for (int lm = 3; lm <= 13; lm += 2) fft_pass_inv(buf, lm);
}
DI float2 cmulf(float2 a, float2 b) { return make_float2(a.x * b.x - a.y * b.y, a.x * b.y + a.y * b.x); }

DI float conv3_bf(const u16* row, int s, float w0, float w1, float w2, float bias) {
  float um = s > 0 ? bf2f(row[s - 1]) : 0.f, u0 = bf2f(row[s]), up = s < S - 1 ? bf2f(row[s + 1]) : 0.f;
  return w0 * um + w1 * u0 + w2 * up + bias;
}
DI float conv3_f(const float* row, int s, int n, float w0, float w1, float w2, float bias) {
  float um = s > 0 ? row[s - 1] : 0.f, u0 = row[s], up = s < n - 1 ? row[s + 1] : 0.f;
  return w0 * um + w1 * u0 + w2 * up + bias;
}

DI float2 unpk(unsigned u) { return make_float2(__uint_as_float(u << 16), __uint_as_float(u & 0xffff0000u)); }
DI void bf4(uint2 v, float (&o)[4]) { o[0] = __uint_as_float(v.x << 16); o[1] = __uint_as_float(v.x & 0xffff0000u); o[2] = __uint_as_float(v.y << 16); o[3] = __uint_as_float(v.y & 0xffff0000u); }
DI void taps4(const u16* ff, const u16* fb, int e0, float (&a)[4], float (&b)[4]) {
  const uint2 fa = *(const uint2*)(ff + e0);
  const uint2 fr = *(const uint2*)(fb + (S - e0 - 4));
  const float b0 = e0 > 0 ? bf2f(fb[S - e0]) : 0.f;
  float r4[4];
  bf4(fa, a); bf4(fr, r4);
  b[0] = b0; b[1] = r4[3]; b[2] = r4[2]; b[3] = r4[1];
}
DI void conv3x4(const u16* row, int e0, float w0, float w1, float w2, float bias, float (&o)[4]) {
  const uint2 c = *(const uint2*)(row + e0);
  const float l = e0 > 0 ? bf2f(row[e0 - 1]) : 0.f;
  const float rr = e0 + 4 < S ? bf2f(row[e0 + 4]) : 0.f;
  float u[4]; bf4(c, u);
  o[0] = w0 * l + w1 * u[0] + w2 * u[1] + bias;
  o[1] = w0 * u[0] + w1 * u[1] + w2 * u[2] + bias;
  o[2] = w0 * u[1] + w1 * u[2] + w2 * u[3] + bias;
  o[3] = w0 * u[2] + w1 * u[3] + w2 * rr + bias;
}
DI void twid(int s, float& c, float& sn) { const float fr = (float)s * (1.0f / 32768.0f); c = __builtin_amdgcn_cosf(fr); sn = -__builtin_amdgcn_sinf(fr); }

DI void bf_last(float2& v0, float2& v1, float2& v2, float2& v3) {
  const float2 a0 = make_float2(v0.x + v2.x, v0.y + v2.y), a2 = make_float2(v0.x - v2.x, v0.y - v2.y);
  const float2 a1 = make_float2(v1.x + v3.x, v1.y + v3.y), t13 = make_float2(v1.x - v3.x, v1.y - v3.y);
  const float2 a3 = make_float2(t13.y, -t13.x);
  v0 = make_float2(a0.x + a1.x, a0.y + a1.y); v1 = make_float2(a0.x - a1.x, a0.y - a1.y);
  v2 = make_float2(a2.x + a3.x, a2.y + a3.y); v3 = make_float2(a2.x - a3.x, a2.y - a3.y);
}
DI void bi_first(float2& v0, float2& v1, float2& v2, float2& v3) {
  const float2 a0 = make_float2(v0.x + v1.x, v0.y + v1.y), a1 = make_float2(v0.x - v1.x, v0.y - v1.y);
  const float2 a2 = make_float2(v2.x + v3.x, v2.y + v3.y), a3 = make_float2(v2.x - v3.x, v2.y - v3.y);
  const float2 u3 = make_float2(-a3.y, a3.x);
  v0 = make_float2(a0.x + a2.x, a0.y + a2.y); v2 = make_float2(a0.x - a2.x, a0.y - a2.y);
  v1 = make_float2(a1.x + u3.x, a1.y + u3.y); v3 = make_float2(a1.x - u3.x, a1.y - u3.y);
}
DI void hyena_job(const Params& p, int ch, unsigned char* smem) {
  const int t = threadIdx.x;
  float2* buf = (float2*)smem;
  float4* buf4 = (float4*)smem;
  float* red = (float*)(smem + 131072);
  unsigned* spec_e = (unsigned*)(p.ws + OFF_H + (size_t)blockIdx.x * 262144);
  unsigned* spec_o = spec_e + 16384;
  const u16* uT = (const u16*)(p.ws + OFF_UT);
  u16* hgT = (u16*)(p.ws + OFF_HGT);
  const u16* filtT = (const u16*)(p.ws + OFF_FILTT);
  unsigned* zs = spec_e + 32768;
#define E0(q) (4 * (t + 512 * (q)))
#define LDS_GET(e0, v0, v1, v2, v3) { const float4 A_ = buf4[(e0) >> 1], B_ = buf4[((e0) >> 1) + 1]; v0 = make_float2(A_.x, A_.y); v1 = make_float2(A_.z, A_.w); v2 = make_float2(B_.x, B_.y); v3 = make_float2(B_.z, B_.w); }
#define LDS_PUT(e0, v0, v1, v2, v3) { buf4[(e0) >> 1] = make_float4(v0.x, v0.y, v1.x, v1.y); buf4[((e0) >> 1) + 1] = make_float4(v2.x, v2.y, v3.x, v3.y); }
#pragma nounroll
  for (int o = 0; o < 2; ++o) {
    const u16* ff = filtT + (size_t)(o * 1024 + ch) * S;
    const u16* fb = filtT + (size_t)(o * 1024 + 512 + ch) * S;
    const float dsk = p.skip[o * 512 + ch];
    __syncthreads();
    float ss = 0.f;
#pragma unroll 2
    for (int q = 0; q < 8; ++q) {
      const int e0 = E0(q);
      float a[4], b[4]; taps4(ff, fb, e0, a, b);
#pragma unroll
      for (int k = 0; k < 4; ++k) ss += a[k] * a[k] + b[k] * b[k];
      LDS_PUT(e0, make_float2(a[0] + b[0], 0.f), make_float2(a[1] + b[1], 0.f), make_float2(a[2] + b[2], 0.f), make_float2(a[3] + b[3], 0.f))
    }
    const float rnorm = rsqrtf(block_sum(ss, red) + EPSF);
    __syncthreads();
    fft_fwd(buf);
#pragma unroll 2
    for (int q = 0; q < 8; ++q) {
      const int e0 = E0(q);
      float a[4], b[4]; taps4(ff, fb, e0, a, b);
      float2 v0, v1, v2, v3; LDS_GET(e0, v0, v1, v2, v3)
      bf_last(v0, v1, v2, v3);
      *(uint4*)(spec_e + e0) = make_uint4(pack2(v0.x, v0.y), pack2(v1.x, v1.y), pack2(v2.x, v2.y), pack2(v3.x, v3.y));
      float2 w[4];
#pragma unroll
      for (int k = 0; k < 4; ++k) { float c, sn; twid(e0 + k, c, sn); const float d = a[k] - b[k]; w[k] = make_float2(d * c, d * sn); }
      LDS_PUT(e0, w[0], w[1], w[2], w[3])
    }
    __syncthreads();
    fft_fwd(buf);
    if (o == 0) {
      const u16* u0 = uT + (size_t)(0 * 1536 + ch) * S;
      const u16* u1 = uT + (size_t)(1 * 1536 + ch) * S;
      const float cw0 = p.cw[0 * 1536 + ch], cw1 = p.cw[1 * 1536 + ch], cw2 = p.cw[2 * 1536 + ch], cbv = p.cb[ch];
#pragma unroll 2
      for (int q = 0; q < 8; ++q) {
        const int e0 = E0(q);
        float za[4], zb[4]; conv3x4(u0, e0, cw0, cw1, cw2, cbv, za); conv3x4(u1, e0, cw0, cw1, cw2, cbv, zb);
        float2 v0, v1, v2, v3; LDS_GET(e0, v0, v1, v2, v3)
        bf_last(v0, v1, v2, v3);
        *(uint4*)(spec_o + e0) = make_uint4(pack2(v0.x, v0.y), pack2(v1.x, v1.y), pack2(v2.x, v2.y), pack2(v3.x, v3.y));
        *(uint4*)(zs + e0) = make_uint4(pack2(za[0], zb[0]), pack2(za[1], zb[1]), pack2(za[2], zb[2]), pack2(za[3], zb[3]));
        LDS_PUT(e0, make_float2(za[0], zb[0]), make_float2(za[1], zb[1]), make_float2(za[2], zb[2]), make_float2(za[3], zb[3]))
      }
    } else {
#pragma unroll 2
      for (int q = 0; q < 8; ++q) {
        const int e0 = E0(q);
        const uint4 uz = *(const uint4*)(zs + e0);
        float2 v0, v1, v2, v3; LDS_GET(e0, v0, v1, v2, v3)
        bf_last(v0, v1, v2, v3);
        *(uint4*)(spec_o + e0) = make_uint4(pack2(v0.x, v0.y), pack2(v1.x, v1.y), pack2(v2.x, v2.y), pack2(v3.x, v3.y));
        LDS_PUT(e0, unpk(uz.x), unpk(uz.y), unpk(uz.z), unpk(uz.w))
      }
    }
    __syncthreads();
    fft_fwd(buf);
#pragma unroll 2
    for (int q = 0; q < 8; ++q) {
      const int e0 = E0(q);
      const uint4 us = *(const uint4*)(spec_e + e0);
      float2 v0, v1, v2, v3; LDS_GET(e0, v0, v1, v2, v3)
      bf_last(v0, v1, v2, v3);
      v0 = cmulf(v0, unpk(us.x)); v1 = cmulf(v1, unpk(us.y)); v2 = cmulf(v2, unpk(us.z)); v3 = cmulf(v3, unpk(us.w));
      bi_first(v0, v1, v2, v3);
      LDS_PUT(e0, v0, v1, v2, v3)
    }
    __syncthreads();
    fft_inv(buf);
#pragma unroll 2
    for (int q = 0; q < 8; ++q) {
      const int e0 = E0(q);
      const uint4 uz = *(const uint4*)(zs + e0);
      float2 v0, v1, v2, v3; LDS_GET(e0, v0, v1, v2, v3)
      *(uint4*)(spec_e + e0) = make_uint4(pack2(v0.x, v0.y), pack2(v1.x, v1.y), pack2(v2.x, v2.y), pack2(v3.x, v3.y));
      const float2 z[4] = {unpk(uz.x), unpk(uz.y), unpk(uz.z), unpk(uz.w)};
      float2 w[4];
#pragma unroll
      for (int k = 0; k < 4; ++k) { float c, sn; twid(e0 + k, c, sn); w[k] = make_float2(z[k].x * c - z[k].y * sn, z[k].x * sn + z[k].y * c); }
      LDS_PUT(e0, w[0], w[1], w[2], w[3])
    }
    __syncthreads();
    fft_fwd(buf);
#pragma unroll 2
    for (int q = 0; q < 8; ++q) {
      const int e0 = E0(q);
      const uint4 us = *(const uint4*)(spec_o + e0);
      float2 v0, v1, v2, v3; LDS_GET(e0, v0, v1, v2, v3)
      bf_last(v0, v1, v2, v3);
      v0 = cmulf(v0, unpk(us.x)); v1 = cmulf(v1, unpk(us.y)); v2 = cmulf(v2, unpk(us.z)); v3 = cmulf(v3, unpk(us.w));
      bi_first(v0, v1, v2, v3);
      LDS_PUT(e0, v0, v1, v2, v3)
    }
    __syncthreads();
    fft_inv(buf);
    const int xc = 512 * (o + 1) + ch;
    const u16* x0r = uT + (size_t)(0 * 1536 + xc) * S;
    const u16* x1r = uT + (size_t)(1 * 1536 + xc) * S;
    const float xw0 = p.cw[0 * 1536 + xc], xw1 = p.cw[1 * 1536 + xc], xw2 = p.cw[2 * 1536 + xc], xbv = p.cb[xc];
    const float sc = rnorm * (1.0f / 32768.0f);
    u16* hg0 = hgT + (size_t)(0 * 512 + ch) * S;
    u16* hg1 = hgT + (size_t)(1 * 512 + ch) * S;
#pragma unroll 2
    for (int q = 0; q < 8; ++q) {
      const int e0 = E0(q);
      const uint4 ue = *(const uint4*)(spec_e + e0);
      const uint4 uz = *(const uint4*)(zs + e0);
      float g0[4], g1[4]; conv3x4(x0r, e0, xw0, xw1, xw2, xbv, g0); conv3x4(x1r, e0, xw0, xw1, xw2, xbv, g1);
      float h0[4] = {1.f, 1.f, 1.f, 1.f}, h1[4] = {1.f, 1.f, 1.f, 1.f};
      if (o == 1) { bf4(*(const uint2*)(hg0 + e0), h0); bf4(*(const uint2*)(hg1 + e0), h1); }
      float2 yo[4]; LDS_GET(e0, yo[0], yo[1], yo[2], yo[3])
      const float2 ye[4] = {unpk(ue.x), unpk(ue.y), unpk(ue.z), unpk(ue.w)};
      const float2 z[4] = {unpk(uz.x), unpk(uz.y), unpk(uz.z), unpk(uz.w)};
      float r0[4], r1[4];
#pragma unroll
      for (int k = 0; k < 4; ++k) {
        float c, sn; twid(e0 + k, c, sn); sn = -sn;
        const float y0 = (ye[k].x + yo[k].x * c - yo[k].y * sn) * sc;
        const float y1 = (ye[k].y + yo[k].x * sn + yo[k].y * c) * sc;
        r0[k] = g0[k] * (y0 + z[k].x * dsk) * h0[k]; r1[k] = g1[k] * (y1 + z[k].y * dsk) * h1[k];
      }
      if (o == 0) *(uint4*)(zs + e0) = make_uint4(pack2(r0[0], r1[0]), pack2(r0[1], r1[1]), pack2(r0[2], r1[2]), pack2(r0[3], r1[3]));
      else {
        *(uint2*)(hg0 + e0) = make_uint2(pack2(r0[0], r0[1]), pack2(r0[2], r0[3]));
        *(uint2*)(hg1 + e0) = make_uint2(pack2(r1[0], r1[1]), pack2(r1[2], r1[3]));
      }
    }
    __syncthreads();
  }
#undef E0
#undef LDS_GET
#undef LDS_PUT
  {
    float* sm = (float*)smem;
    float* hf = sm;
    float* hb = sm + 256;
    float* zc = sm + 512;
    const float* utc = (const float*)(p.ws + OFF_UTC);
    const float* hgc = (const float*)(p.ws + OFF_HGTC);
    const float* flc = (const float*)(p.ws + OFF_FILTTC);
    const int b = t >> 8, tt = t & 255;
    const float cw0 = p.cw[0 * 1536 + ch], cw1 = p.cw[1 * 1536 + ch], cw2 = p.cw[2 * 1536 + ch], cbv = p.cb[ch];
    __syncthreads();
    zc[b * 256 + tt] = conv3_f(utc + (size_t)(b * 1536 + ch) * NC, tt, NC, cw0, cw1, cw2, cbv);
    for (int o = 0; o < 2; ++o) {
      float tap = flc[(size_t)(o * 1024 + b * 512 + ch) * NC + tt];
      float sq = (b == 1 && tt == 0) ? 0.f : tap * tap;
      const float rnorm = rsqrtf(block_sum(sq, red) + EPSF);
      if (b == 0) sm[255 + tt] = tap; else if (tt > 0) sm[255 - tt] = tap;
      __syncthreads();
      float a = 0.f;
      {
        const float* tp = sm + 255 + tt;
        const float4* z4 = (const float4*)(zc + b * 256);
#pragma unroll 4
        for (int s4 = 0; s4 < 64; ++s4) {
          const float4 zv = z4[s4];
          a += tp[-(4 * s4)] * zv.x; a += tp[-(4 * s4 + 1)] * zv.y; a += tp[-(4 * s4 + 2)] * zv.z; a += tp[-(4 * s4 + 3)] * zv.w;
        }
      }
      const int xc = 512 * (o + 1) + ch;
      const float g = conv3_f(utc + (size_t)(b * 1536 + xc) * NC, tt, NC, p.cw[0 * 1536 + xc], p.cw[1 * 1536 + xc], p.cw[2 * 1536 + xc], p.cb[xc]);
      const float res = g * (a * rnorm + zc[b * 256 + tt] * p.skip[o * 512 + ch]);
      __syncthreads();
      if (o == 0) zc[b * 256 + tt] = res;
      else {
        const float hg = hgc[(size_t)(b * 512 + ch) * NC + tt];
        ((u16*)(p.ws + OFF_Y))[(size_t)(MLAT + b * NC + tt) * 1024 + 512 + ch] = f2bf(res * hg);
      }
      __syncthreads();
    }
  }
}

DI void phase3(const Params& p, unsigned char* smem, bool do_h, bool do_a) {
  const int w = threadIdx.x >> 6, lane = threadIdx.x & 63, r = lane & 31;
#pragma nounroll
  for (int it = blockIdx.x; it < (do_h ? 512 : 0); it += gridDim.x) hyena_job(p, it, smem);
#pragma nounroll
  for (int it = blockIdx.x; it < (do_a ? 1024 + 16 : 0); it += gridDim.x) {
    __syncthreads();
    const bool isc = it >= 1024;
    const int u = isc ? it - 1024 : it;
    const int b = isc ? (u >> 3) : (u >> 9), kvh = isc ? ((u >> 2) & 1) : ((u >> 8) & 1), qt = isc ? (u & 3) : (u & 255);
    const int head = kvh * 4 + (w >> 1); const int q0 = qt * 64 + (w & 1) * 32;
    const u16* Qw = isc ? (const u16*)(p.ws + OFF_QC) + ((size_t)(b * 8 + head) * NC + q0) * 64
                        : (const u16*)(p.ws + OFF_Q) + ((size_t)(b * 8 + head) * S + q0) * 64;
    u16* yrow = (u16*)(p.ws + OFF_Y) + (size_t)((isc ? MLAT + b * NC : b * S) + q0 + r) * 1024 + head * 64;
    attn_unit<0>(Qw, (const u16*)(p.ws + OFF_K) + (size_t)(b * 2 + kvh) * KTOT * 64,
                 (const u16*)(p.ws + OFF_VT) + (size_t)(b * 2 + kvh) * 64 * KTOT,
                 isc ? NC / 64 : KTOT / 64, 0, 0, q0, 0, 0.f, nullptr, yrow, smem);
  }
}

DI void phase4(const Params& p, unsigned char* smem) {
  u16* tile = (u16*)smem;
  const u16* src = (const u16*)(p.ws + OFF_HGT);
  u16* y = (u16*)(p.ws + OFF_Y);
  const int t = threadIdx.x;
  if (blockIdx.x < 8) { uint4 q0_, q1_, q2_, q3_, q4_, q5_, q6_, q7_; gemm_tile<2>(p, (const u16*)(p.ws + OFF_Y), (const u16*)(p.ws + OFF_WOUTT), MLAT + (blockIdx.x >> 2) * 256, (blockIdx.x & 3) * 256, smem, q0_, q1_, q2_, q3_, q4_, q5_, q6_, q7_, false, 0, 0, false); return; }
  for (int it = blockIdx.x - 8; it < 4096; it += gridDim.x - 8) {
    const int b = it >> 11, ct = (it >> 8) & 7, st = it & 255;
    __syncthreads();
#pragma unroll
    for (int i = 0; i < 8; ++i) { int e = t + 512 * i; int c = e >> 6, s = e & 63; tile[c * 66 + s] = src[(size_t)(b * 512 + ct * 64 + c) * S + st * 64 + s]; }
    __syncthreads();
#pragma unroll
    for (int i = 0; i < 8; ++i) { int e = t + 512 * i; int s = e >> 6, c = e & 63; y[(size_t)(b * S + st * 64 + s) * 1024 + 512 + ct * 64 + c] = tile[c * 66 + s]; }
  }
}

DI void phase8(const Params& p, unsigned char* smem) {
  const int w = threadIdx.x >> 6, lane = threadIdx.x & 63, r = lane & 31;
  float* rpbs = (float*)(smem + 73728);
  for (int it = blockIdx.x; it < 2048; it += gridDim.x) {
    __syncthreads();
    if (it < 1024) {
      const int u = it; const int b = u >> 9, kvh = (u >> 8) & 1, qt = u & 255;
      const int head = kvh * 4 + (w >> 1); const int q0 = qt * 64 + (w & 1) * 32;
      int lo = qt * 64 - 128; if (lo < 0) lo = 0;
      int hi = qt * 64 + 192; if (hi > S) hi = S;
      attn_unit<1>((const u16*)(p.ws + OFF_QW) + ((size_t)(b * 8 + head) * S + q0) * 64,
                   (const u16*)(p.ws + OFF_KW) + (size_t)(b * 2 + kvh) * KTOT * 64,
                   (const u16*)(p.ws + OFF_VWT) + (size_t)(b * 2 + kvh) * 64 * KTOT,
                   NC / 64, NC + lo, (hi - lo) / 64, q0, 0, p.sink[head] * LOG2E, nullptr,
                   (u16*)(p.ws + OFF_Y) + (size_t)(b * S + q0 + r) * 1024 + head * 64, smem);
    } else {
      const int u = it - 1024; const int b = u >> 9, head = (u >> 6) & 7, rt = u & 63;
      const int R0 = rt * 4;
      for (int e = threadIdx.x; e < 465; e += 512) rpbs[e] = p.rpb[head * 465 + e] * LOG2E;
      int rlo = R0 - 4; rlo = rlo < 0 ? 0 : (rlo > 248 ? 248 : rlo);
      int rhi = R0 + 3 - 4; rhi = rhi < 0 ? 0 : (rhi > 248 ? 248 : rhi); rhi += 7;
      const int qr = R0 + (w >> 1); const int q0 = qr * 64 + (w & 1) * 32;
      attn_unit<2>((const u16*)(p.ws + OFF_QN) + ((size_t)(b * 8 + head) * S + q0) * 64,
                   (const u16*)(p.ws + OFF_KN) + (size_t)(b * 8 + head) * KTOT * 64,
                   (const u16*)(p.ws + OFF_VNT) + (size_t)(b * 8 + head) * 64 * KTOT,
                   NC / 64, NC + rlo * 64, rhi - rlo + 1, q0, qr, 0.f, rpbs,
                   (u16*)(p.ws + OFF_Y) + (size_t)(b * S + q0 + r) * 1024 + 512 + head * 64, smem);
    }
  }
}

#define XB_TMO      128
#define XB_XCNT(j)  (256  + 64 * (j))
#define XB_XSUB(j)  (1280 + 64 * (j))
#define XB_XGEN(j)  (2304 + 64 * (j))
#define XB_TOP      3328
#define XB_TOPGEN   3392
#define XCD_BAR_WORDS 3456
#define XB_SPIN_CAP (1u << 18)
#define LAS __attribute__((address_space(3)))

__device__ __forceinline__ unsigned xb_ld(unsigned* p)              { return __hip_atomic_load(p, __ATOMIC_RELAXED, __HIP_MEMORY_SCOPE_AGENT); }
__device__ __forceinline__ unsigned xb_add(unsigned* p, unsigned v) { return __hip_atomic_fetch_add(p, v, __ATOMIC_RELAXED, __HIP_MEMORY_SCOPE_AGENT); }
__device__ __forceinline__ unsigned xb_xcc_id() { return (unsigned)__builtin_amdgcn_s_getreg((3 << 11) | 20) & 0xFu; }
#define XB_SPIN(cond, bar) do { unsigned _sp = 0; while (cond) { __builtin_amdgcn_s_sleep(1); \
    if ((++_sp & 255u) == 0u) { if (xb_ld(&(bar)[XB_TMO])) break; if (_sp > XB_SPIN_CAP) { atomicAdd(&(bar)[XB_TMO], 1u); break; } } } } while (0)

struct XcdBarrier {
    unsigned* bar; unsigned x;
    volatile LAS unsigned* st;
};

__device__ __forceinline__ XcdBarrier xcd_barrier_post(unsigned* bar, volatile LAS unsigned* st) {
    XcdBarrier b; b.bar = bar; b.x = xb_xcc_id(); b.st = st;
    if (threadIdx.x == 0) (void)xb_add(&bar[XB_XCNT(b.x)], 1u);
    return b;
}
__device__ __forceinline__ void xcd_barrier_complete(unsigned* bar, unsigned x, unsigned& nloc, unsigned& nx) {
    const unsigned G = gridDim.x * gridDim.y * gridDim.z;
    unsigned sum, cnt, mine, sp = 0u;
    for (;;) {
        sum = 0u; cnt = 0u; mine = 0u;
#pragma unroll
        for (unsigned j = 0; j < 16; ++j) { const unsigned c = xb_ld(&bar[XB_XCNT(j)]); sum += c; cnt += (c > 0u) ? 1u : 0u; mine = (j == x) ? c : mine; }
        if (sum == G) break;
        __builtin_amdgcn_s_sleep(1);
        if ((++sp & 255u) == 0u) { if (xb_ld(&bar[XB_TMO])) break; if (sp > XB_SPIN_CAP) { atomicAdd(&bar[XB_TMO], 1u); break; } }
    }
    nloc = mine > 0u ? mine : 1u; nx = cnt > 0u ? cnt : 1u;
}

__device__ __forceinline__ void xcd_barrier(const XcdBarrier& b) {
    asm volatile("s_waitcnt vmcnt(0)" ::: "memory");
    __syncthreads();
    if (threadIdx.x == 0) {
        unsigned* bar = b.bar;
        __builtin_amdgcn_s_waitcnt(0);
        unsigned nloc = b.st[0], nx = b.st[1];
        if (nloc == 0u) { xcd_barrier_complete(bar, b.x, nloc, nx); b.st[0] = nloc; b.st[1] = nx; }
        const unsigned old = xb_add(&bar[XB_XSUB(b.x)], 1u);
        const unsigned gen = old / nloc;
        if (old + 1u == (gen + 1u) * nloc) {
            __builtin_amdgcn_fence(__ATOMIC_RELEASE, "agent");
            asm volatile("s_waitcnt vmcnt(0)" ::: "memory");
            const unsigned og = xb_add(&bar[XB_TOP], 1u);
            const unsigned tg = og / nx;
            if (og + 1u == (tg + 1u) * nx) xb_add(&bar[XB_TOPGEN], 1u);
            else XB_SPIN(xb_ld(&bar[XB_TOPGEN]) == tg, bar);
            __builtin_amdgcn_fence(__ATOMIC_ACQUIRE, "agent");
            xb_add(&bar[XB_XGEN(b.x)], 1u);
            asm volatile("s_waitcnt vmcnt(0)" ::: "memory");
        } else {
            XB_SPIN(xb_ld(&bar[XB_XGEN(b.x)]) == gen, bar);
            __builtin_amdgcn_fence(__ATOMIC_ACQUIRE, "agent");
            asm volatile("s_waitcnt vmcnt(0)" ::: "memory");
        }
    }
    __syncthreads();
}


__global__ void __launch_bounds__(NTHR) hybrid_fwd(Params p) {
  extern __shared__ __attribute__((aligned(16))) unsigned char smem[];
  cg::grid_group grid = cg::this_grid();
  const u16* h = (const u16*)(p.ws + OFF_H);
  const u16* y = (const u16*)(p.ws + OFF_Y);
  const u16* winT = (const u16*)(p.ws + OFF_WINT);
  const u16* woutT = (const u16*)(p.ws + OFF_WOUTT);
#ifndef PROBE
#define PROBE 0
#endif
  volatile LAS unsigned* xst = (volatile LAS unsigned*)(smem + 147456);
  if (threadIdx.x == 0) { xst[0] = 0u; xst[1] = 0u; xst[2] = 0u; xst[3] = 0u; }
  __syncthreads();
  const XcdBarrier xb = xcd_barrier_post((unsigned*)(p.ws + OFF_BAR), xst);
#define STEP(stmt) if (PH(__LINE__)) { stmt; xcd_barrier(xb); }
  if (p.phase_hi < 0) grid.sync();
  STEP(phase0(p, smem))
  STEP(phase1(p, smem))
#if PROBE == 8
  for (int i = 0; i < 10; ++i) grid.sync();
#endif
  STEP(gemm_phase<0>(p, h, winT, MALL / 256, INW / 256, 4, smem))
#if PROBE == 1
  STEP(phase3(p, smem, false, true))
  STEP(gemm_phase<0>(p, h, winT, MALL / 256, INW / 256, 4, smem))
#endif
#if PROBE == 7
  STEP(phase3(p, smem, true, false))
  STEP(phase1(p, smem))
  STEP(gemm_phase<0>(p, h, winT, MALL / 256, INW / 256, 4, smem))
#endif
  STEP(phase3(p, smem, true, true))
#if PROBE == 6
  STEP(phase1(p, smem))
#endif
#if PROBE == 2
  STEP(phase1(p, smem))
  STEP(gemm_phase<0>(p, h, winT, MALL / 256, INW / 256, 4, smem))
  STEP(phase3(p, smem, true, true))
#endif
  STEP(phase4(p, smem))
  STEP(gemm_phase<2>(p, y, woutT, MLAT / 256, 4, 8, smem))
#if PROBE == 4
  STEP(gemm_phase<2>(p, y, woutT, MLAT / 256, 4, 8, smem))
#endif
  STEP(for (int it = blockIdx.x; it < 2080; it += gridDim.x) modnorm_rows(p, 1, it))
  STEP(gemm_phase<1>(p, h, winT + (size_t)INW * 1024, MALL / 256, INW / 256, 4, smem))
#if PROBE == 3
  STEP(gemm_phase<1>(p, h, winT + (size_t)INW * 1024, MALL / 256, INW / 256, 4, smem))
#endif
#if PROBE == 5
  STEP(phase8(p, smem))
  STEP(gemm_phase<1>(p, h, winT + (size_t)INW * 1024, MALL / 256, INW / 256, 4, smem))
#endif
  STEP(phase8(p, smem))
  gemm_phase<3>(p, y, woutT + (size_t)1024 * 1024, MLAT / 256, 4, 8, smem);
}

extern "C" void kernel_launch(void* const* d_in, const int* in_sizes, int n_in, void* d_out, int out_size, void* d_ws, size_t ws_size, hipStream_t stream) {
  static int grid_blocks = 0;
  if (grid_blocks == 0) {
    if (n_in != 26 || ws_size < WS_NEED) { fprintf(stderr, "kernel_launch: unexpected n_in %d or ws_size %zu (need %zu)\n", n_in, ws_size, (size_t)WS_NEED); grid_blocks = -1; return; }
    int dev = 0, cus = 0, per_cu = 0;
    hipGetDevice(&dev);
    hipDeviceGetAttribute(&cus, hipDeviceAttributeMultiprocessorCount, dev);
    if (hipFuncSetAttribute((const void*)hybrid_fwd, hipFuncAttributeMaxDynamicSharedMemorySize, LDS_BYTES) != hipSuccess) { fprintf(stderr, "kernel_launch: hipFuncSetAttribute failed\n"); grid_blocks = -1; return; }
    if (hipOccupancyMaxActiveBlocksPerMultiprocessor(&per_cu, (const void*)hybrid_fwd, NTHR, LDS_BYTES) != hipSuccess || per_cu < 1) { fprintf(stderr, "kernel_launch: occupancy query failed (%d)\n", per_cu); grid_blocks = -1; return; }
    int g = cus * per_cu; if (g > 256) g = 256;
    grid_blocks = g;
  }
  if (grid_blocks < 0) return;
  Params p{};
  const float* const* in = (const float* const*)d_in;
  p.x = in[0]; p.c = in[1]; p.ctx = in[2]; p.c_ctx = in[3]; p.norm_g = in[4]; p.w_ada = in[5]; p.b_ada = in[6]; p.w_in = in[7]; p.w_out = in[8];
  p.gq = in[9]; p.gk = in[10]; p.cw = in[11]; p.cb = in[12]; p.w1 = in[13]; p.b1 = in[14]; p.w2 = in[15]; p.b2 = in[16]; p.fr = in[17]; p.w3 = in[18]; p.skip = in[19];
  p.wqn = in[20]; p.wkn = in[21]; p.sink = in[22]; p.nqn = in[23]; p.nkn = in[24]; p.rpb = in[25];
  p.out = (float*)d_out; p.ws = (unsigned char*)d_ws;
  p.phase_lo = 0; p.phase_hi = 10;
  if (hipMemsetAsync((unsigned char*)d_ws + OFF_BAR, 0, XCD_BAR_WORDS * sizeof(unsigned), stream) != hipSuccess) { fprintf(stderr, "kernel_launch: memset of the barrier words failed\n"); return; }
  void* args[] = {&p};
  hipError_t e = hipLaunchCooperativeKernel((const void*)hybrid_fwd, dim3(grid_blocks), dim3(NTHR), args, LDS_BYTES, stream);
  if (e != hipSuccess) fprintf(stderr, "kernel_launch: cooperative launch failed: %s (grid %d)\n", hipGetErrorString(e), grid_blocks);
}
```

```cpp
#include <hip/hip_runtime.h>
#include <hip/hip_cooperative_groups.h>
#include <cstdio>
#include <cstdint>
namespace cg = cooperative_groups;

typedef unsigned short u16;
using bf16x8 = __attribute__((ext_vector_type(8))) short;
using f32x16 = __attribute__((ext_vector_type(16))) float;
typedef __bf16 bf16x2_t __attribute__((ext_vector_type(2)));
#define DI __device__ __forceinline__
#define MFMA(a, b, c) __builtin_amdgcn_mfma_f32_32x32x16_bf16((a), (b), (c), 0, 0, 0)

constexpr int S = 16384, DM = 1024, NB = 2, NC = 256, INW = 3328;
constexpr int KTOT = S + NC;
constexpr int MLAT = NB * S;
constexpr int MALL = MLAT + NB * NC;
constexpr int NTHR = 512;
constexpr float LOG2E = 1.4426950408889634f;
constexpr float QSCALE = 0.125f * LOG2E;
constexpr float EPSF = 1e-6f;
constexpr size_t MiB = 1024 * 1024;
constexpr size_t OFF_MOD = 0;
constexpr size_t OFF_ROPE = 128 * 1024;
constexpr size_t OFF_BAR = 512 * 1024;
constexpr size_t OFF_WINT = 1 * MiB;
constexpr size_t OFF_WOUTT = 15 * MiB;
constexpr size_t OFF_HDN2 = 19 * MiB;
constexpr size_t OFF_HDN2C = 23 * MiB;
constexpr size_t OFF_XC1 = 24 * MiB;
constexpr size_t OFF_FILTTC = 26 * MiB;
constexpr size_t OFF_QC = 28 * MiB;
constexpr size_t OFF_UTC = 29 * MiB;
constexpr size_t OFF_HGTC = 32 * MiB;
constexpr size_t OFF_H = 34 * MiB;
constexpr size_t OFF_Y = 99 * MiB;
constexpr size_t OFF_FILTT = 164 * MiB;
constexpr size_t OFF_Q = 292 * MiB;
constexpr size_t OFF_K = 324 * MiB;
constexpr size_t OFF_VT = 333 * MiB;
constexpr size_t OFF_UT = 342 * MiB;
constexpr size_t OFF_HGT = 438 * MiB;
constexpr size_t WS_NEED = 470 * MiB;
constexpr size_t OFF_QW = 164 * MiB;
constexpr size_t OFF_KW = 196 * MiB;
constexpr size_t OFF_VWT = 205 * MiB;
constexpr size_t OFF_QN = 214 * MiB;
constexpr size_t OFF_KN = 246 * MiB;
constexpr size_t OFF_VNT = 279 * MiB;
constexpr int LDS_BYTES = 147456 + 16;

#ifndef ONLY_PHASE
#define ONLY_PHASE -1
#endif
#define PH(k) (ONLY_PHASE < 0 || ONLY_PHASE == (k))
struct Params {
  const float *x, *c, *ctx, *c_ctx, *norm_g, *w_ada, *b_ada, *w_in, *w_out;
  const float *gq, *gk, *cw, *cb, *w1, *b1, *w2, *b2, *fr, *w3, *skip;
  const float *wqn, *wkn, *sink, *nqn, *nkn, *rpb;
  float* out;
  unsigned char* ws;
  int phase_lo, phase_hi;
};

DI unsigned pack2(float a, float b) { bf16x2_t v = {(__bf16)a, (__bf16)b}; return __builtin_bit_cast(unsigned, v); }
DI unsigned pack2a(float a, float b) { unsigned r; asm("v_cvt_pk_bf16_f32 %0, %1, %2" : "=v"(r) : "v"(a), "v"(b)); return r; }
DI u16 f2bf(float a) { return __builtin_bit_cast(u16, (__bf16)a); }
DI float bf2f(u16 v) { return __uint_as_float(((unsigned)v) << 16); }
DI float siluf(float v) { return v / (1.f + __expf(-v)); }
DI int crow(int reg, int h) { return (reg & 3) + 8 * (reg >> 2) + 4 * h; }
DI float wave_sum(float v) {
#pragma unroll
  for (int o = 32; o >= 1; o >>= 1) v += __shfl_xor(v, o);
  return v;
}
DI float block_sum(float v, float* red) {
  v = wave_sum(v);
  __syncthreads();
  if ((threadIdx.x & 63) == 0) red[threadIdx.x >> 6] = v;
  __syncthreads();
  float s = 0.f;
#pragma unroll
  for (int i = 0; i < 8; ++i) s += red[i];
  return s;
}

DI void p0_transpose(const float* W, int K, int N, u16* WT, int k0, int n0, float* tile) {
  const int t = threadIdx.x;
  __syncthreads();
#pragma unroll
  for (int i = 0; i < 8; ++i) { int e = t + 512 * i; int kk = e >> 6, nn = e & 63; tile[kk * 65 + nn] = W[(size_t)(k0 + kk) * N + n0 + nn]; }
  __syncthreads();
#pragma unroll
  for (int i = 0; i < 8; ++i) { int e = t + 512 * i; int nn = e >> 6, kk = e & 63; WT[(size_t)(n0 + nn) * K + k0 + kk] = f2bf(tile[kk * 65 + nn]); }
}

DI void p0_adaln(const Params& p, int l, int nc, float* sm) {
  const int t = threadIdx.x;
  float* mod = (float*)(p.ws + OFF_MOD);
  __syncthreads();
  for (int e = t; e < 3072; e += 512) { int v = e >> 10, k = e & 1023; float cv = v < 2 ? p.c[v * 1024 + k] : p.c_ctx[k]; sm[e] = cv / (1.f + expf(-cv)); }
  __syncthreads();
  const int n = t & 63, kg = t >> 6;
  const float* W = p.w_ada + (size_t)l * 1024 * 3072 + nc * 64 + n;
  float a0 = 0.f, a1 = 0.f, a2 = 0.f;
  for (int k = kg * 128; k < kg * 128 + 128; ++k) { float w = W[(size_t)k * 3072]; a0 += sm[k] * w; a1 += sm[1024 + k] * w; a2 += sm[2048 + k] * w; }
  float* red = sm + 3072;
  red[(kg * 3 + 0) * 64 + n] = a0; red[(kg * 3 + 1) * 64 + n] = a1; red[(kg * 3 + 2) * 64 + n] = a2;
  __syncthreads();
  if (t < 192) {
    int v = t >> 6; float s = 0.f;
    for (int g = 0; g < 8; ++g) s += red[(g * 3 + v) * 64 + n];
    mod[(l * 3 + v) * 3072 + nc * 64 + n] = s + p.b_ada[l * 3072 + nc * 64 + n];
  }
}

DI void p0_mlp(const Params& p, int tbase, int n, float* dst, float* sm) {
  const int t = threadIdx.x, tl = t >> 6, j = t & 63;
  float* zs = sm;
  float* hs = sm + 8 * 36;
  float* w1s = sm + 1024;
  float* w2s = w1s + 33 * 64;
  __syncthreads();
  for (int e = t; e < 33 * 64; e += 512) w1s[e] = p.w1[e];
  for (int e = t; e < 64 * 64; e += 512) w2s[e] = p.w2[e];
  const float frj = p.fr[j], b1j = p.b1[j], b2j = p.b2[j];
#pragma nounroll
  for (int g = 0; g < 8; ++g) {
    const int tt = tbase + g * 8 + tl;
    __syncthreads();
    if (j < 33) {
      float val;
      if (j == 0) val = (float)tt / (float)(n - 1);
      else {
        const float w = (6.283185307179586f * (float)tt) / (float)n;
        const int i = (j - 1) & 15;
        const float f = 1e-4f + (float)i * ((15.0f - 1e-4f) / 15.0f);
        val = (j <= 16) ? cosf(f * w) : -sinf(f * w);
      }
      zs[tl * 36 + j] = val;
    }
    __syncthreads();
    float a = b1j;
#pragma unroll
    for (int i = 0; i < 33; ++i) a += zs[tl * 36 + i] * w1s[i * 64 + j];
    hs[tl * 64 + j] = sinf(frj * a);
    __syncthreads();
    float a2 = b2j;
#pragma unroll
    for (int i = 0; i < 64; ++i) a2 += hs[tl * 64 + i] * w2s[i * 64 + j];
    dst[(size_t)tt * 64 + j] = sinf(frj * a2);
  }
}

DI void phase0(const Params& p, unsigned char* smem) {
  float* sm = (float*)smem;
  for (int it = blockIdx.x; it < 2533; it += gridDim.x) {
    if (it < 1664) {
      int l = it / 832, rem = it % 832; int kt = rem / 52, nt = rem % 52;
      p0_transpose(p.w_in + (size_t)l * 1024 * INW, 1024, INW, (u16*)(p.ws + OFF_WINT) + (size_t)l * INW * 1024, kt * 64, nt * 64, sm);
    } else if (it < 2176) {
      int i2 = it - 1664; int l = i2 >> 8, rem = i2 & 255; int kt = rem >> 4, nt = rem & 15;
      p0_transpose(p.w_out + (size_t)l * 1024 * 1024, 1024, 1024, (u16*)(p.ws + OFF_WOUTT) + (size_t)l * 1024 * 1024, kt * 64, nt * 64, sm);
    } else if (it < 2272) {
      int i2 = it - 2176; p0_adaln(p, i2 / 48, i2 % 48, sm);
    } else if (it < 2528) {
      p0_mlp(p, (it - 2272) * 64, S, (float*)(p.ws + OFF_HDN2), sm);
    } else if (it < 2532) {
      p0_mlp(p, (it - 2528) * 64, NC, (float*)(p.ws + OFF_HDN2C), sm);
    } else {
      float2* tab = (float2*)(p.ws + OFF_ROPE);
      for (int e = threadIdx.x; e < 5120; e += 512) {
        int pos = e >> 4, pi = e & 15; float pv = (float)(pos < 256 ? pos : pos - 256);
        float inv = powf(10000.0f, -(float)pi / 16.0f);
        float ang = pv * inv; float sn, cs; sincosf(ang, &sn, &cs);
        tab[e] = make_float2(cs, sn);
      }
    }
  }
}

DI void modnorm_rows(const Params& p, int layer, int item) {
  const int w = threadIdx.x >> 6, lane = threadIdx.x & 63;
  const float* g = p.norm_g + layer * 1024;
  const float* src[2]; const float* md[2]; int rowi[2];
#pragma unroll
  for (int j = 0; j < 2; ++j) {
    const int row = item * 16 + j * 8 + w; int v;
    if (row < MLAT) { src[j] = (layer == 0 ? p.x : (const float*)p.out) + (size_t)row * 1024; v = row >> 14; }
    else { src[j] = (layer == 0 ? p.ctx : (const float*)(p.ws + OFF_XC1)) + (size_t)(row - MLAT) * 1024; v = 2; }
    md[j] = (const float*)(p.ws + OFF_MOD) + (layer * 3 + v) * 3072; rowi[j] = row;
  }
  float4 xv[2][4]; float ss[2] = {0.f, 0.f};
#pragma unroll
  for (int j = 0; j < 2; ++j)
#pragma unroll
    for (int i = 0; i < 4; ++i) xv[j][i] = *(const float4*)(src[j] + i * 256 + lane * 4);
#pragma unroll
  for (int j = 0; j < 2; ++j) {
#pragma unroll
    for (int i = 0; i < 4; ++i) ss[j] += xv[j][i].x * xv[j][i].x + xv[j][i].y * xv[j][i].y + xv[j][i].z * xv[j][i].z + xv[j][i].w * xv[j][i].w;
    ss[j] = wave_sum(ss[j]);
  }
#pragma unroll
  for (int j = 0; j < 2; ++j) {
    const float rstd = rsqrtf(ss[j] * (1.f / 1024.f) + EPSF);
    u16* h = (u16*)(p.ws + OFF_H) + (size_t)rowi[j] * 1024;
#pragma unroll
    for (int i = 0; i < 4; ++i) {
      const int col = i * 256 + lane * 4;
      const float4 g4 = *(const float4*)(g + col), sh = *(const float4*)(md[j] + col), sc = *(const float4*)(md[j] + 1024 + col);
      float y0 = xv[j][i].x * rstd * g4.x * (1.f + sc.x) + sh.x, y1 = xv[j][i].y * rstd * g4.y * (1.f + sc.y) + sh.y;
      float y2 = xv[j][i].z * rstd * g4.z * (1.f + sc.z) + sh.z, y3 = xv[j][i].w * rstd * g4.w * (1.f + sc.w) + sh.w;
      *(uint2*)(h + col) = make_uint2(pack2(y0, y1), pack2(y2, y3));
    }
  }
}

DI void filt_item(const Params& p, int tb, int cg) {
  const int t = threadIdx.x, lane = t & 63, w = t >> 6, r = lane & 31, h = lane >> 5;
  const bool isctx = (tb == 64);
  const int n = isctx ? NC : S;
  const float* hd = isctx ? (const float*)(p.ws + OFF_HDN2C) : (const float*)(p.ws + OFF_HDN2);
  float* dst = isctx ? (float*)(p.ws + OFF_FILTTC) : (float*)(p.ws + OFF_FILTT);
  const int t0 = (isctx ? 0 : tb * 256) + w * 32;
  float bv[32];
  const float* hr = hd + (size_t)(t0 + r) * 64 + h * 32;
#pragma unroll
  for (int i = 0; i < 8; ++i) { float4 q4 = *(const float4*)(hr + i * 4); bv[4 * i] = q4.x; bv[4 * i + 1] = q4.y; bv[4 * i + 2] = q4.z; bv[4 * i + 3] = q4.w; }
  const float tl2 = -((float)(t0 + r) / (float)(n - 1)) * LOG2E;
  const float da = -3.0701134573253945f, db = -15.350567286626972f;
#pragma nounroll
  for (int ct = 0; ct < 16; ++ct) {
    const int col0 = cg * 512 + ct * 32;
    const float* wp = p.w3 + (size_t)(h * 32) * 2048 + col0 + r;
    f32x16 acc;
#pragma unroll
    for (int i = 0; i < 16; ++i) acc[i] = 0.f;
#pragma unroll
    for (int s = 0; s < 32; ++s) acc = __builtin_amdgcn_mfma_f32_32x32x2f32(wp[(size_t)s * 2048], bv[s], acc, 0, 0, 0);
#pragma unroll
    for (int reg = 0; reg < 16; ++reg) {
      const int col = col0 + crow(reg, h); const int ch = col & 511;
      const float delta = da + (db - da) * ((float)ch / 511.0f);
      const float dec = __builtin_amdgcn_exp2f(tl2 * fabsf(delta));
      if (isctx) dst[(size_t)col * n + t0 + r] = acc[reg] * dec;
      else ((u16*)dst)[(size_t)col * n + t0 + r] = f2bf(acc[reg] * dec);
    }
  }
}

DI void phase1(const Params& p, unsigned char* smem) {
  for (int it = blockIdx.x; it < 256; it += gridDim.x) filt_item(p, it >> 2, it & 3);
  for (int it = blockIdx.x; it < 2080 + 4; it += gridDim.x) {
    if (it < 2080) modnorm_rows(p, 0, it); else filt_item(p, 64, it - 2080);
  }
}

DI float head_rstd(const f32x16& a0, const f32x16& a1) {
  float ss = 0.f;
#pragma unroll
  for (int i = 0; i < 16; ++i) ss += a0[i] * a0[i] + a1[i] * a1[i];
  ss += __shfl_xor(ss, 32);
  return rsqrtf(ss * (1.f / 64.f) + EPSF);
}
DI void store_qk(const f32x16& a0, const f32x16& a1, const float* gn, bool rope, int tpos, float scale, u16* dst, const float2* tab, int h) {
  const float rstd = head_rstd(a0, a1) ;
#pragma unroll
  for (int ni = 0; ni < 2; ++ni) {
#pragma unroll
    for (int q = 0; q < 4; ++q) {
      const int f0 = ni * 32 + 8 * q + 4 * h;
      const float4 g4 = *(const float4*)(gn + f0);
      float v0 = (ni == 0 ? a0[4 * q] : a1[4 * q]) * rstd * g4.x;
      float v1 = (ni == 0 ? a0[4 * q + 1] : a1[4 * q + 1]) * rstd * g4.y;
      float v2 = (ni == 0 ? a0[4 * q + 2] : a1[4 * q + 2]) * rstd * g4.z;
      float v3 = (ni == 0 ? a0[4 * q + 3] : a1[4 * q + 3]) * rstd * g4.w;
      if (rope) {
        const int pa = 4 * q + 2 * h;
        const float2* tr = (ni == 0) ? (tab + (tpos >> 6) * 16) : (tab + (256 + (tpos & 63)) * 16);
        const float2 ca = tr[pa], cb = tr[pa + 1];
        float r0 = v0 * ca.x - v1 * ca.y, r1 = v0 * ca.y + v1 * ca.x;
        float r2 = v2 * cb.x - v3 * cb.y, r3 = v2 * cb.y + v3 * cb.x;
        v0 = r0; v1 = r1; v2 = r2; v3 = r3;
      }
      *(uint2*)(dst + f0) = make_uint2(pack2(v0 * scale, v1 * scale), pack2(v2 * scale, v3 * scale));
    }
  }
}
DI void store_T_bf16(const f32x16& a0, const f32x16& a1, u16* dst, size_t pitch, int h, bool dosilu) {
#pragma unroll
  for (int ni = 0; ni < 2; ++ni)
#pragma unroll
    for (int reg = 0; reg < 16; ++reg) {
      float v = ni == 0 ? a0[reg] : a1[reg];
      if (dosilu) v = siluf(v);
      dst[(size_t)(ni * 32 + crow(reg, h)) * pitch] = f2bf(v);
    }
}
DI void store_T_f32(const f32x16& a0, const f32x16& a1, float* dst, size_t pitch, int h, bool dosilu) {
#pragma unroll
  for (int ni = 0; ni < 2; ++ni)
#pragma unroll
    for (int reg = 0; reg < 16; ++reg) {
      float v = ni == 0 ? a0[reg] : a1[reg];
      if (dosilu) v = siluf(v);
      dst[(size_t)(ni * 32 + crow(reg, h)) * pitch] = v;
    }
}
DI void store_silu_row(const f32x16& a0, const f32x16& a1, u16* dst, int h) {
#pragma unroll
  for (int ni = 0; ni < 2; ++ni)
#pragma unroll
    for (int q = 0; q < 4; ++q) {
      const int f0 = ni * 32 + 8 * q + 4 * h;
      float v0 = siluf(ni == 0 ? a0[4 * q] : a1[4 * q]), v1 = siluf(ni == 0 ? a0[4 * q + 1] : a1[4 * q + 1]);
      float v2 = siluf(ni == 0 ? a0[4 * q + 2] : a1[4 * q + 2]), v3 = siluf(ni == 0 ? a0[4 * q + 3] : a1[4 * q + 3]);
      *(uint2*)(dst + f0) = make_uint2(pack2(v0, v1), pack2(v2, v3));
    }
}

template <int EPI>
DI void gemm_epilogue(const Params& p, f32x16 (&acc)[2][4], int nb, int mb, int r, int h) {
  unsigned char* ws = p.ws;
  const float2* tab = (const float2*)(ws + OFF_ROPE);
  const bool isctx = mb >= MLAT;
#pragma unroll
  for (int mi = 0; mi < 4; ++mi) {
    const int mrow = mb + mi * 32 + r;
    const int b = isctx ? ((mrow - MLAT) >> 8) : (mrow >> 14);
    const int tpos = isctx ? ((mrow - MLAT) & 255) : (mrow & (S - 1));
    const int kpos = isctx ? tpos : NC + tpos;
    const f32x16& a0 = acc[0][mi];
    const f32x16& a1 = acc[1][mi];
    if (EPI == 0) {
      if (nb < 512) {
        const int head = nb >> 6;
        u16* dst = isctx ? (u16*)(ws + OFF_QC) + ((size_t)(b * 8 + head) * NC + tpos) * 64 : (u16*)(ws + OFF_Q) + ((size_t)(b * 8 + head) * S + tpos) * 64;
        store_qk(a0, a1, p.gq, !isctx, tpos, QSCALE, dst, tab, h);
      } else if (nb < 640) {
        const int kvh = (nb - 512) >> 6;
        store_qk(a0, a1, p.gk, !isctx, tpos, 1.f, (u16*)(ws + OFF_K) + ((size_t)(b * 2 + kvh) * KTOT + kpos) * 64, tab, h);
      } else if (nb < 768) {
        const int kvh = (nb - 640) >> 6;
        store_T_bf16(a0, a1, (u16*)(ws + OFF_VT) + (size_t)(b * 2 + kvh) * 64 * KTOT + kpos, KTOT, h, false);
      } else if (nb < 2304) {
        const int ch = nb - 768;
        if (isctx) store_T_f32(a0, a1, (float*)(ws + OFF_UTC) + (size_t)(b * 1536 + ch) * NC + tpos, NC, h, false);
        else store_T_bf16(a0, a1, (u16*)(ws + OFF_UT) + (size_t)(b * 1536 + ch) * S + tpos, S, h, false);
      } else if (nb < 2816) {
        store_silu_row(a0, a1, (u16*)(ws + OFF_Y) + (size_t)mrow * 1024 + (nb - 2304), h);
      } else {
        const int ch = nb - 2816;
        if (isctx) store_T_f32(a0, a1, (float*)(ws + OFF_HGTC) + (size_t)(b * 512 + ch) * NC + tpos, NC, h, true);
        else store_T_bf16(a0, a1, (u16*)(ws + OFF_HGT) + (size_t)(b * 512 + ch) * S + tpos, S, h, true);
      }
    } else if (EPI == 1) {
      if (nb < 512) {
        if (!isctx) store_qk(a0, a1, p.wqn, true, tpos, QSCALE, (u16*)(ws + OFF_QW) + ((size_t)(b * 8 + (nb >> 6)) * S + tpos) * 64, tab, h);
      } else if (nb < 640) {
        const int kvh = (nb - 512) >> 6;
        store_qk(a0, a1, p.wkn, !isctx, tpos, 1.f, (u16*)(ws + OFF_KW) + ((size_t)(b * 2 + kvh) * KTOT + kpos) * 64, tab, h);
      } else if (nb < 768) {
        const int kvh = (nb - 640) >> 6;
        store_T_bf16(a0, a1, (u16*)(ws + OFF_VWT) + (size_t)(b * 2 + kvh) * 64 * KTOT + kpos, KTOT, h, false);
      } else if (nb < 1280) {
        if (!isctx) store_qk(a0, a1, p.nqn, false, tpos, QSCALE, (u16*)(ws + OFF_QN) + ((size_t)(b * 8 + ((nb - 768) >> 6)) * S + tpos) * 64, tab, h);
      } else if (nb < 1792) {
        const int head = (nb - 1280) >> 6;
        store_qk(a0, a1, p.nkn, false, tpos, 1.f, (u16*)(ws + OFF_KN) + ((size_t)(b * 8 + head) * KTOT + kpos) * 64, tab, h);
      } else if (nb < 2304) {
        const int head = (nb - 1792) >> 6;
        store_T_bf16(a0, a1, (u16*)(ws + OFF_VNT) + (size_t)(b * 8 + head) * 64 * KTOT + kpos, KTOT, h, false);
      } else {
        if (!isctx) store_silu_row(a0, a1, (u16*)(ws + OFF_Y) + (size_t)mrow * 1024 + (nb - 2304), h);
      }
    } else {
      const int layer = EPI - 2;
      const float* gate = (const float*)(ws + OFF_MOD) + (layer * 3 + (isctx ? 2 : b)) * 3072 + 2048;
      const float* src; float* dst;
      if (isctx) { src = p.ctx + (size_t)(mrow - MLAT) * 1024; dst = (float*)(ws + OFF_XC1) + (size_t)(mrow - MLAT) * 1024; }
      else { src = (layer == 0 ? p.x : (const float*)p.out) + (size_t)mrow * 1024; dst = p.out + (size_t)mrow * 1024; }
#pragma unroll
      for (int ni = 0; ni < 2; ++ni)
#pragma unroll
        for (int q = 0; q < 4; ++q) {
          const int n = nb + ni * 32 + 8 * q + 4 * h;
          const float4 g4 = *(const float4*)(gate + n);
          const float4 x4 = *(const float4*)(src + n);
          float4 o;
          o.x = x4.x + g4.x * (ni == 0 ? a0[4 * q] : a1[4 * q]);
          o.y = x4.y + g4.y * (ni == 0 ? a0[4 * q + 1] : a1[4 * q + 1]);
          o.z = x4.z + g4.z * (ni == 0 ? a0[4 * q + 2] : a1[4 * q + 2]);
          o.w = x4.w + g4.w * (ni == 0 ? a0[4 * q + 3] : a1[4 * q + 3]);
          *(float4*)(dst + n) = o;
        }
    }
  }
}

template <int EPI>
DI void gemm_tile(const Params& p, const u16* A, const u16* WT, int m0, int n0, unsigned char* smem, uint4& gw0, uint4& gw1, uint4& gw2, uint4& gw3, uint4& ga0, uint4& ga1, uint4& ga2, uint4& ga3, bool pre, int nm0, int nn0, bool has_next) {
  const int t = threadIdx.x, lane = t & 63, w = t >> 6, r = lane & 31, h = lane >> 5;
  const int wn = w & 3, wm = w >> 2;
  constexpr int ST = 256 * 72;
  u16* sW = (u16*)smem;
  u16* sA = sW + 2 * ST;
  f32x16 acc[2][4];
#pragma unroll
  for (int i = 0; i < 2; ++i)
#pragma unroll
    for (int j = 0; j < 4; ++j)
#pragma unroll
      for (int k = 0; k < 16; ++k) acc[i][j][k] = 0.f;
  const u16* gW = WT + (size_t)(n0 + (t >> 3)) * 1024 + (t & 7) * 8;
  const u16* gA = A + (size_t)(m0 + (t >> 3)) * 1024 + (t & 7) * 8;
  const int lo = (t >> 3) * 72 + (t & 7) * 8;
#define GLOADP(PW, PA, k0) { gw0 = *(const uint4*)((PW) + (k0)); gw1 = *(const uint4*)((PW) + 64 * 1024 + (k0)); gw2 = *(const uint4*)((PW) + 128 * 1024 + (k0)); gw3 = *(const uint4*)((PW) + 192 * 1024 + (k0)); \
                             ga0 = *(const uint4*)((PA) + (k0)); ga1 = *(const uint4*)((PA) + 64 * 1024 + (k0)); ga2 = *(const uint4*)((PA) + 128 * 1024 + (k0)); ga3 = *(const uint4*)((PA) + 192 * 1024 + (k0)); }
#define GLOAD(k0) GLOADP(gW, gA, k0)
#define LSTORE(nx) { *(uint4*)(sW + (nx) + lo) = gw0; *(uint4*)(sW + (nx) + lo + 64 * 72) = gw1; *(uint4*)(sW + (nx) + lo + 128 * 72) = gw2; *(uint4*)(sW + (nx) + lo + 192 * 72) = gw3; \
                     *(uint4*)(sA + (nx) + lo) = ga0; *(uint4*)(sA + (nx) + lo + 64 * 72) = ga1; *(uint4*)(sA + (nx) + lo + 128 * 72) = ga2; *(uint4*)(sA + (nx) + lo + 192 * 72) = ga3; }
  const int rot = (blockIdx.x >> 3) & 15;
  if (!pre) GLOAD(rot * 64)
  LSTORE(0)
  GLOAD(((1 + rot) & 15) * 64)
#pragma nounroll
  for (int kt = 0; kt < 16; ++kt) {
    const int cur = kt & 1;
    __syncthreads();
    if (kt < 15) {
      LSTORE((cur ^ 1) * ST)
      if (kt < 14) GLOAD(((kt + 2 + rot) & 15) * 64)
    }
    const u16* cw = sW + cur * ST + (wn * 64 + r) * 72 + h * 8;
    const u16* ca = sA + cur * ST + (wm * 128 + r) * 72 + h * 8;
#pragma unroll
    for (int ks = 0; ks < 4; ++ks) {
      bf16x8 af0 = *(const bf16x8*)(cw + ks * 16), af1 = *(const bf16x8*)(cw + 32 * 72 + ks * 16);
      bf16x8 b0 = *(const bf16x8*)(ca + ks * 16), b1 = *(const bf16x8*)(ca + 32 * 72 + ks * 16);
      bf16x8 b2 = *(const bf16x8*)(ca + 64 * 72 + ks * 16), b3 = *(const bf16x8*)(ca + 96 * 72 + ks * 16);
      acc[0][0] = MFMA(af0, b0, acc[0][0]); acc[0][1] = MFMA(af0, b1, acc[0][1]); acc[0][2] = MFMA(af0, b2, acc[0][2]); acc[0][3] = MFMA(af0, b3, acc[0][3]);
      acc[1][0] = MFMA(af1, b0, acc[1][0]); acc[1][1] = MFMA(af1, b1, acc[1][1]); acc[1][2] = MFMA(af1, b2, acc[1][2]); acc[1][3] = MFMA(af1, b3, acc[1][3]);
    }
  }
  __syncthreads();
  if (has_next) {
    const u16* nW = WT + (size_t)(nn0 + (t >> 3)) * 1024 + (t & 7) * 8;
    const u16* nA = A + (size_t)(nm0 + (t >> 3)) * 1024 + (t & 7) * 8;
    GLOADP(nW, nA, rot * 64)
  }
#undef GLOAD
#undef GLOADP
#undef LSTORE
  gemm_epilogue<EPI>(p, acc, n0 + wn * 64, m0 + wm * 128, r, h);
}

template <int EPI>
DI void gemm_phase(const Params& p, const u16* A, const u16* WT, int mtiles, int ntiles, int srm, unsigned char* smem) {
  const int bpg = gridDim.x >> 3;
  const int xg = blockIdx.x & 7, li = blockIdx.x >> 3;
  const int nsr = (mtiles + srm - 1) / srm;
  const int per_sr = srm * ntiles;
  const int total = nsr * per_sr;
  auto tile_at = [&](int j, int& mt, int& nt) -> bool {
    const int lin = (j * 8 + xg) * bpg + li;
    if (lin >= total || li >= bpg) return false;
    const int sr = lin / per_sr, rem = lin % per_sr;
    nt = rem / srm; mt = sr * srm + rem % srm;
    return mt < mtiles;
  };
  int j = 0, mt = 0, nt = 0; bool have = false;
  for (; j * 8 * bpg < total; ++j) if (tile_at(j, mt, nt)) { have = true; break; }
  uint4 gw0, gw1, gw2, gw3, ga0, ga1, ga2, ga3; bool pre = false;
#pragma nounroll
  while (have) {
    int j2 = j + 1, mt2 = 0, nt2 = 0; bool have2 = false;
    for (; j2 * 8 * bpg < total; ++j2) if (tile_at(j2, mt2, nt2)) { have2 = true; break; }
    gemm_tile<EPI>(p, A, WT, mt * 256, nt * 256, smem, gw0, gw1, gw2, gw3, ga0, ga1, ga2, ga3, pre, mt2 * 256, nt2 * 256, have2);
    pre = have2; have = have2; j = j2; mt = mt2; nt = nt2;
  }
}

template <int MODE>
DI void attn_unit(const u16* Qw, const u16* Kb, const u16* VTb, int nt0, int seg1_lo, int nt1,
                  int tqw  , int qr  , float sinkl2, const float* rpbs,
                  u16* yrow  , unsigned char* smem) {
  const int t = threadIdx.x, lane = t & 63, r = lane & 31, h = lane >> 5;
  constexpr int STG = 2 * 64 * 72;
  u16* sKV = (u16*)smem;
  const int ntiles = nt0 + nt1;
  const int lrow = t >> 3, lc = t & 7;
  const int kofs = lrow * 72 + lc * 8;
  const int vofs0 = 64 * 72 + lrow * 72 + 16 * (lc >> 1) + 4 * (lc & 1), vofs1 = vofs0 + 8;
  uint4 rk, rv;
  const int toff = 0;
#define KEY0(i) ((MODE == 0) ? ((((i) + toff) >= nt0 ? (i) + toff - nt0 : (i) + toff) * 64) : (((i) < nt0) ? (i) * 64 : seg1_lo + ((i) - nt0) * 64))
#define TLOAD(i) { const int k0_ = KEY0(i); rk = *(const uint4*)(Kb + (size_t)(k0_ + lrow) * 64 + lc * 8); rv = *(const uint4*)(VTb + (size_t)lrow * KTOT + k0_ + lc * 8); }
#define TSTORE(st) { u16* d_ = sKV + (st) * STG; *(uint4*)(d_ + kofs) = rk; *(uint2*)(d_ + vofs0) = make_uint2(rv.x, rv.y); *(uint2*)(d_ + vofs1) = make_uint2(rv.z, rv.w); }
  TLOAD(0)
  bf16x8 qf[4];
#pragma unroll
  for (int ks = 0; ks < 4; ++ks) qf[ks] = *(const bf16x8*)(Qw + r * 64 + ks * 16 + h * 8);
  TSTORE(0)
  if (ntiles > 1) { TLOAD(1) TSTORE(1) }
  { u16* d_ = sKV + 3 * STG; *(uint2*)(d_ + vofs0) = make_uint2(0u, 0u); *(uint2*)(d_ + vofs1) = make_uint2(0u, 0u); }
  __syncthreads();
  f32x16 o0, o1, sc0, sc1, negm;
#pragma unroll
  for (int i = 0; i < 16; ++i) { o0[i] = 0.f; o1[i] = 0.f; sc0[i] = 0.f; sc1[i] = 0.f; negm[i] = 0.f; }
  {
    const u16* ck = sKV + r * 72 + h * 8;
#pragma unroll
    for (int ks = 0; ks < 4; ++ks) {
      bf16x8 k0f = *(const bf16x8*)(ck + ks * 16), k1f = *(const bf16x8*)(ck + 32 * 72 + ks * 16);
      sc0 = MFMA(k0f, qf[ks], sc0); sc1 = MFMA(k1f, qf[ks], sc1);
    }
  }
  bf16x8 pp[4];
#pragma unroll
  for (int i = 0; i < 4; ++i) pp[i] = bf16x8{0, 0, 0, 0, 0, 0, 0, 0};
  float m = -1e30f, lsum = 0.f;
  float mref_c = 0.f;
  float mref_n = 0.f;
  const int tq = tqw + r;
  const int qc = tq & 63;
  int c0 = qc - 8; c0 = c0 < 0 ? 0 : (c0 > 48 ? 48 : c0);
  int r0w = qr - 4; r0w = r0w < 0 ? 0 : (r0w > 248 ? 248 : r0w);
  bool pend = false; float apend = 1.f;
  uint4 rk2, rv2;
#define TLOADR(i, RK, RV) { const int k0_ = KEY0(i); RK = *(const uint4*)(Kb + (size_t)(k0_ + lrow) * 64 + lc * 8); RV = *(const uint4*)(VTb + (size_t)lrow * KTOT + k0_ + lc * 8); }
#define TSTORER(st, RK, RV) { u16* d_ = sKV + (st) * STG; *(uint4*)(d_ + kofs) = RK; *(uint2*)(d_ + vofs0) = make_uint2(RV.x, RV.y); *(uint2*)(d_ + vofs1) = make_uint2(RV.z, RV.w); }
  constexpr bool DEEP = (MODE == 0);
  { const int i2 = (2 < ntiles) ? 2 : ntiles - 1; TLOADR(i2, rk, rv) }
  if (DEEP) { const int i3 = (3 < ntiles) ? 3 : ntiles - 1; TLOADR(i3, rk2, rv2) }
  auto step = [&](const int i, uint4& lk, uint4& lv) __attribute__((always_inline)) {
    TSTORER((i + 2) & 3, lk, lv)
    if (pend) {
#pragma unroll
      for (int j = 0; j < 16; ++j) { o0[j] *= apend; o1[j] *= apend; if (MODE == 0) negm[j] = -m; }
      if (MODE == 0) mref_n = m;
    }
    { const int ahead = DEEP ? i + 4 : i + 3; const int inx = (ahead < ntiles) ? ahead : ntiles - 1; TLOADR(inx, lk, lv) }
    f32x16 sn0, sn1;
    {
      const u16* ck = sKV + ((i + 1) & 3) * STG + r * 72 + h * 8;
      {
        bf16x8 k0f = *(const bf16x8*)(ck), k1f = *(const bf16x8*)(ck + 32 * 72);
        sn0 = MFMA(k0f, qf[0], negm); sn1 = MFMA(k1f, qf[0], negm);
      }
#pragma unroll
      for (int ks = 1; ks < 4; ++ks) {
        bf16x8 k0f = *(const bf16x8*)(ck + ks * 16), k1f = *(const bf16x8*)(ck + 32 * 72 + ks * 16);
        sn0 = MFMA(k0f, qf[ks], sn0); sn1 = MFMA(k1f, qf[ks], sn1);
      }
    }
    const float mref_next = mref_n;
    const bool seg1 = (i >= nt0);
    const int tk0 = KEY0(i) - NC;
    if (MODE == 1 && seg1) {
#pragma unroll
      for (int j = 0; j < 16; ++j) {
        const int tk = tk0 + crow(j, h);
        int d0 = tq - tk; d0 = d0 < 0 ? -d0 : d0;
        int d1 = tq - (tk + 32); d1 = d1 < 0 ? -d1 : d1;
        if (d0 > 128) sc0[j] = -1e30f;
        if (d1 > 128) sc1[j] = -1e30f;
      }
    }
    if (MODE == 2 && seg1) {
      const int kr = tk0 >> 6;
      const bool rowok = (kr >= r0w) && (kr < r0w + 8);
      int krel = kr - qr + 7; krel = krel < 0 ? 0 : (krel > 14 ? 14 : krel);
      const float* br = rpbs + krel * 31 + 15 - qc;
#pragma unroll
      for (int j = 0; j < 16; ++j) {
        const int kc0 = crow(j, h), kc1 = kc0 + 32;
        const bool v0 = rowok && (kc0 >= c0) && (kc0 < c0 + 16);
        const bool v1 = rowok && (kc1 >= c0) && (kc1 < c0 + 16);
        sc0[j] = v0 ? sc0[j] + br[v0 ? kc0 : qc] : -1e30f;
        sc1[j] = v1 ? sc1[j] + br[v1 ? kc1 : qc] : -1e30f;
      }
    }
    float mt = fmaxf(sc0[0], sc1[0]);
#pragma unroll
    for (int j = 1; j < 16; ++j) mt = fmaxf(fmaxf(mt, sc0[j]), sc1[j]);
    mt = fmaxf(mt, __shfl_xor(mt, 32));
    mt += mref_c;
    const bool resc = __builtin_amdgcn_ballot_w64(mt > m + 8.0f) != 0;
    float alpha = 1.f;
    if (resc) { const float mnew = fmaxf(m, mt); alpha = __builtin_amdgcn_exp2f(m - mnew); m = mnew; lsum *= alpha; }
    if (__builtin_amdgcn_ballot_w64(mref_c != m) != 0) {
      const float dlt = mref_c - m;
#pragma unroll
      for (int j = 0; j < 16; ++j) { sc0[j] += dlt; sc1[j] += dlt; }
    }
    float ps0 = 0.f, ps1 = 0.f;
#pragma unroll
    for (int j = 0; j < 16; ++j) { sc0[j] = __builtin_amdgcn_exp2f(sc0[j]); sc1[j] = __builtin_amdgcn_exp2f(sc1[j]); ps0 += sc0[j]; ps1 += sc1[j]; }
    lsum += ps0 + ps1;
    bf16x8 pc[4];
#pragma unroll
    for (int ss = 0; ss < 2; ++ss) {
      pc[ss] = __builtin_bit_cast(bf16x8, make_uint4(pack2a(sc0[8 * ss + 0], sc0[8 * ss + 1]), pack2a(sc0[8 * ss + 2], sc0[8 * ss + 3]), pack2a(sc0[8 * ss + 4], sc0[8 * ss + 5]), pack2a(sc0[8 * ss + 6], sc0[8 * ss + 7])));
      pc[2 + ss] = __builtin_bit_cast(bf16x8, make_uint4(pack2a(sc1[8 * ss + 0], sc1[8 * ss + 1]), pack2a(sc1[8 * ss + 2], sc1[8 * ss + 3]), pack2a(sc1[8 * ss + 4], sc1[8 * ss + 5]), pack2a(sc1[8 * ss + 6], sc1[8 * ss + 7])));
    }
    {
      const u16* cv = sKV + ((i + 3) & 3) * STG + 64 * 72 + r * 72 + h * 8;
#pragma unroll
      for (int ks = 0; ks < 4; ++ks) {
        bf16x8 v0f = *(const bf16x8*)(cv + ks * 16), v1f = *(const bf16x8*)(cv + 32 * 72 + ks * 16);
        o0 = MFMA(v0f, pp[ks], o0); o1 = MFMA(v1f, pp[ks], o1);
      }
    }
    pend = resc; apend = alpha;
    __syncthreads();
    sc0 = sn0; sc1 = sn1; mref_c = mref_next;
#pragma unroll
    for (int ks = 0; ks < 4; ++ks) pp[ks] = pc[ks];
    };
  if (DEEP) {
#pragma nounroll
    for (int i = 0; i < ntiles; i += 2) { step(i, rk, rv); if (i + 1 < ntiles) step(i + 1, rk2, rv2); }
  } else {
#pragma nounroll
    for (int i = 0; i < ntiles; ++i) step(i, rk, rv);
  }
#undef TLOADR
#undef TSTORER
  if (pend) {
#pragma unroll
    for (int j = 0; j < 16; ++j) { o0[j] *= apend; o1[j] *= apend; }
  }
  {
    const u16* cv = sKV + ((ntiles + 3) & 3) * STG + 64 * 72 + r * 72 + h * 8;
#pragma unroll
    for (int ks = 0; ks < 4; ++ks) {
      bf16x8 v0f = *(const bf16x8*)(cv + ks * 16), v1f = *(const bf16x8*)(cv + 32 * 72 + ks * 16);
      o0 = MFMA(v0f, pp[ks], o0); o1 = MFMA(v1f, pp[ks], o1);
    }
  }
#undef KEY0
#undef TLOAD
#undef TSTORE
  float l = lsum + __shfl_xor(lsum, 32);
  if (MODE == 1) l += __builtin_amdgcn_exp2f(sinkl2 - m);
  const float inv = 1.f / l;
#pragma unroll
  for (int di = 0; di < 2; ++di)
#pragma unroll
    for (int q = 0; q < 4; ++q) {
      const int d0 = di * 32 + 8 * q + 4 * h;
      uint2 g = *(const uint2*)(yrow + d0);
      float v0 = (di == 0 ? o0[4 * q] : o1[4 * q]) * inv * bf2f((u16)(g.x & 0xffff));
      float v1 = (di == 0 ? o0[4 * q + 1] : o1[4 * q + 1]) * inv * bf2f((u16)(g.x >> 16));
      float v2 = (di == 0 ? o0[4 * q + 2] : o1[4 * q + 2]) * inv * bf2f((u16)(g.y & 0xffff));
      float v3 = (di == 0 ? o0[4 * q + 3] : o1[4 * q + 3]) * inv * bf2f((u16)(g.y >> 16));
      *(uint2*)(yrow + d0) = make_uint2(pack2(v0, v1), pack2(v2, v3));
    }
}

typedef float v2f __attribute__((ext_vector_type(2)));
DI v2f cmulv(v2f a, v2f cs, v2f ncs) { return a.xx * cs + a.yy * ncs; }
DI void fft_pass_fwd(float2* buf_, int lm) {
  v2f* buf = (v2f*)buf_;
  const int m = 1 << lm, hm = m >> 1;
  const float rinv = 1.0f / (float)(2 * m);
#pragma unroll 4
  for (int q = 0; q < 8; ++q) {
    const int j = threadIdx.x + 512 * q;
    const int blk = j >> (lm - 1), idx = j & (hm - 1);
    const int i0 = (blk << (lm + 1)) + idx;
    v2f e0 = buf[i0], e1 = buf[i0 + hm], e2 = buf[i0 + m], e3 = buf[i0 + m + hm];
    const float fr = (float)idx * rinv;
    const float c = __builtin_amdgcn_cosf(fr), s = -__builtin_amdgcn_sinf(fr);
    const v2f cs = {c, s}, ncs = {-s, c};
    const float c2 = c * c - s * s, s2 = 2.f * c * s;
    const v2f cs2 = {c2, s2}, ncs2 = {-s2, c2};
    v2f a0 = e0 + e2;
    v2f a2 = cmulv(e0 - e2, cs, ncs);
    v2f a1 = e1 + e3;
    v2f t13 = cmulv(e1 - e3, cs, ncs);
    v2f a3 = {t13.y, -t13.x};
    buf[i0] = a0 + a1;
    buf[i0 + hm] = cmulv(a0 - a1, cs2, ncs2);
    buf[i0 + m] = a2 + a3;
    buf[i0 + m + hm] = cmulv(a2 - a3, cs2, ncs2);
  }
  __syncthreads();
}
DI void fft_pass_inv(float2* buf_, int lm) {
  v2f* buf = (v2f*)buf_;
  const int m = 1 << lm, hm = m >> 1;
  const float rinv = 1.0f / (float)(2 * m);
#pragma unroll 4
  for (int q = 0; q < 8; ++q) {
    const int j = threadIdx.x + 512 * q;
    const int blk = j >> (lm - 1), idx = j & (hm - 1);
    const int i0 = (blk << (lm + 1)) + idx;
    v2f b0 = buf[i0], b1 = buf[i0 + hm], b2 = buf[i0 + m], b3 = buf[i0 + m + hm];
    const float fr = (float)idx * rinv;
    const float c = __builtin_amdgcn_cosf(fr), s = __builtin_amdgcn_sinf(fr);
    const v2f cs = {c, s}, ncs = {-s, c};
    const float c2 = c * c - s * s, s2 = 2.f * c * s;
    const v2f cs2 = {c2, s2}, ncs2 = {-s2, c2};
    v2f t1 = cmulv(b1, cs2, ncs2), t3 = cmulv(b3, cs2, ncs2);
    v2f a0 = b0 + t1, a1 = b0 - t1, a2 = b2 + t3, a3 = b2 - t3;
    v2f u2 = cmulv(a2, cs, ncs);
    v2f u3r = cmulv(a3, cs, ncs);
    v2f u3 = {-u3r.y, u3r.x};
    buf[i0] = a0 + u2;
    buf[i0 + m] = a0 - u2;
    buf[i0 + hm] = a1 + u3;
    buf[i0 + m + hm] = a1 - u3;
  }
  __syncthreads();
}
DI void fft_fwd(float2* buf) {
#pragma nounroll
  for (int lm = 13; lm >= 3; lm -= 2) fft_pass_fwd(buf, lm);
}
DI void fft_inv(float2* buf) {
#pragma nounroll
  for (int lm = 3; lm <= 13; lm += 2) fft_pass_inv(buf, lm);
}
DI float2 cmulf(float2 a, float2 b) { return make_float2(a.x * b.x - a.y * b.y, a.x * b.y + a.y * b.x); }

DI float conv3_bf(const u16* row, int s, float w0, float w1, float w2, float bias) {
  float um = s > 0 ? bf2f(row[s - 1]) : 0.f, u0 = bf2f(row[s]), up = s < S - 1 ? bf2f(row[s + 1]) : 0.f;
  return w0 * um + w1 * u0 + w2 * up + bias;
}
DI float conv3_f(const float* row, int s, int n, float w0, float w1, float w2, float bias) {
  float um = s > 0 ? row[s - 1] : 0.f, u0 = row[s], up = s < n - 1 ? row[s + 1] : 0.f;
  return w0 * um + w1 * u0 + w2 * up + bias;
}

DI float2 unpk(unsigned u) { return make_float2(__uint_as_float(u << 16), __uint_as_float(u & 0xffff0000u)); }
DI void bf4(uint2 v, float (&o)[4]) { o[0] = __uint_as_float(v.x << 16); o[1] = __uint_as_float(v.x & 0xffff0000u); o[2] = __uint_as_float(v.y << 16); o[3] = __uint_as_float(v.y & 0xffff0000u); }
DI void taps4(const u16* ff, const u16* fb, int e0, float (&a)[4], float (&b)[4]) {
  const uint2 fa = *(const uint2*)(ff + e0);
  const uint2 fr = *(const uint2*)(fb + (S - e0 - 4));
  const float b0 = e0 > 0 ? bf2f(fb[S - e0]) : 0.f;
  float r4[4];
  bf4(fa, a); bf4(fr, r4);
  b[0] = b0; b[1] = r4[3]; b[2] = r4[2]; b[3] = r4[1];
}
DI void conv3x4(const u16* row, int e0, float w0, float w1, float w2, float bias, float (&o)[4]) {
  const uint2 c = *(const uint2*)(row + e0);
  const float l = e0 > 0 ? bf2f(row[e0 - 1]) : 0.f;
  const float rr = e0 + 4 < S ? bf2f(row[e0 + 4]) : 0.f;
  float u[4]; bf4(c, u);
  o[0] = w0 * l + w1 * u[0] + w2 * u[1] + bias;
  o[1] = w0 * u[0] + w1 * u[1] + w2 * u[2] + bias;
  o[2] = w0 * u[1] + w1 * u[2] + w2 * u[3] + bias;
  o[3] = w0 * u[2] + w1 * u[3] + w2 * rr + bias;
}
DI void twid(int s, float& c, float& sn) { const float fr = (float)s * (1.0f / 32768.0f); c = __builtin_amdgcn_cosf(fr); sn = -__builtin_amdgcn_sinf(fr); }

DI void bf_last(float2& v0, float2& v1, float2& v2, float2& v3) {
  const float2 a0 = make_float2(v0.x + v2.x, v0.y + v2.y), a2 = make_float2(v0.x - v2.x, v0.y - v2.y);
  const float2 a1 = make_float2(v1.x + v3.x, v1.y + v3.y), t13 = make_float2(v1.x - v3.x, v1.y - v3.y);
  const float2 a3 = make_float2(t13.y, -t13.x);
  v0 = make_float2(a0.x + a1.x, a0.y + a1.y); v1 = make_float2(a0.x - a1.x, a0.y - a1.y);
  v2 = make_float2(a2.x + a3.x, a2.y + a3.y); v3 = make_float2(a2.x - a3.x, a2.y - a3.y);
}
DI void bi_first(float2& v0, float2& v1, float2& v2, float2& v3) {
  const float2 a0 = make_float2(v0.x + v1.x, v0.y + v1.y), a1 = make_float2(v0.x - v1.x, v0.y - v1.y);
  const float2 a2 = make_float2(v2.x + v3.x, v2.y + v3.y), a3 = make_float2(v2.x - v3.x, v2.y - v3.y);
  const float2 u3 = make_float2(-a3.y, a3.x);
  v0 = make_float2(a0.x + a2.x, a0.y + a2.y); v2 = make_float2(a0.x - a2.x, a0.y - a2.y);
  v1 = make_float2(a1.x + u3.x, a1.y + u3.y); v3 = make_float2(a1.x - u3.x, a1.y - u3.y);
}
DI void hyena_job(const Params& p, int ch, unsigned char* smem) {
  const int t = threadIdx.x;
  float2* buf = (float2*)smem;
  float4* buf4 = (float4*)smem;
  float* red = (float*)(smem + 131072);
  unsigned* spec_e = (unsigned*)(p.ws + OFF_H + (size_t)blockIdx.x * 262144);
  unsigned* spec_o = spec_e + 16384;
  const u16* uT = (const u16*)(p.ws + OFF_UT);
  u16* hgT = (u16*)(p.ws + OFF_HGT);
  const u16* filtT = (const u16*)(p.ws + OFF_FILTT);
  unsigned* zs = spec_e + 32768;
#define E0(q) (4 * (t + 512 * (q)))
#define LDS_GET(e0, v0, v1, v2, v3) { const float4 A_ = buf4[(e0) >> 1], B_ = buf4[((e0) >> 1) + 1]; v0 = make_float2(A_.x, A_.y); v1 = make_float2(A_.z, A_.w); v2 = make_float2(B_.x, B_.y); v3 = make_float2(B_.z, B_.w); }
#define LDS_PUT(e0, v0, v1, v2, v3) { buf4[(e0) >> 1] = make_float4(v0.x, v0.y, v1.x, v1.y); buf4[((e0) >> 1) + 1] = make_float4(v2.x, v2.y, v3.x, v3.y); }
#pragma nounroll
  for (int o = 0; o < 2; ++o) {
    const u16* ff = filtT + (size_t)(o * 1024 + ch) * S;
    const u16* fb = filtT + (size_t)(o * 1024 + 512 + ch) * S;
    const float dsk = p.skip[o * 512 + ch];
    __syncthreads();
    float ss = 0.f;
#pragma unroll 2
    for (int q = 0; q < 8; ++q) {
      const int e0 = E0(q);
      float a[4], b[4]; taps4(ff, fb, e0, a, b);
#pragma unroll
      for (int k = 0; k < 4; ++k) ss += a[k] * a[k] + b[k] * b[k];
      LDS_PUT(e0, make_float2(a[0] + b[0], 0.f), make_float2(a[1] + b[1], 0.f), make_float2(a[2] + b[2], 0.f), make_float2(a[3] + b[3], 0.f))
    }
    const float rnorm = rsqrtf(block_sum(ss, red) + EPSF);
    __syncthreads();
    fft_fwd(buf);
#pragma unroll 2
    for (int q = 0; q < 8; ++q) {
      const int e0 = E0(q);
      float a[4], b[4]; taps4(ff, fb, e0, a, b);
      float2 v0, v1, v2, v3; LDS_GET(e0, v0, v1, v2, v3)
      bf_last(v0, v1, v2, v3);
      *(uint4*)(spec_e + e0) = make_uint4(pack2(v0.x, v0.y), pack2(v1.x, v1.y), pack2(v2.x, v2.y), pack2(v3.x, v3.y));
      float2 w[4];
#pragma unroll
      for (int k = 0; k < 4; ++k) { float c, sn; twid(e0 + k, c, sn); const float d = a[k] - b[k]; w[k] = make_float2(d * c, d * sn); }
      LDS_PUT(e0, w[0], w[1], w[2], w[3])
    }
    __syncthreads();
    fft_fwd(buf);
    if (o == 0) {
      const u16* u0 = uT + (size_t)(0 * 1536 + ch) * S;
      const u16* u1 = uT + (size_t)(1 * 1536 + ch) * S;
      const float cw0 = p.cw[0 * 1536 + ch], cw1 = p.cw[1 * 1536 + ch], cw2 = p.cw[2 * 1536 + ch], cbv = p.cb[ch];
#pragma unroll 2
      for (int q = 0; q < 8; ++q) {
        const int e0 = E0(q);
        float za[4], zb[4]; conv3x4(u0, e0, cw0, cw1, cw2, cbv, za); conv3x4(u1, e0, cw0, cw1, cw2, cbv, zb);
        float2 v0, v1, v2, v3; LDS_GET(e0, v0, v1, v2, v3)
        bf_last(v0, v1, v2, v3);
        *(uint4*)(spec_o + e0) = make_uint4(pack2(v0.x, v0.y), pack2(v1.x, v1.y), pack2(v2.x, v2.y), pack2(v3.x, v3.y));
        *(uint4*)(zs + e0) = make_uint4(pack2(za[0], zb[0]), pack2(za[1], zb[1]), pack2(za[2], zb[2]), pack2(za[3], zb[3]));
        LDS_PUT(e0, make_float2(za[0], zb[0]), make_float2(za[1], zb[1]), make_float2(za[2], zb[2]), make_float2(za[3], zb[3]))
      }
    } else {
#pragma unroll 2
      for (int q = 0; q < 8; ++q) {
        const int e0 = E0(q);
        const uint4 uz = *(const uint4*)(zs + e0);
        float2 v0, v1, v2, v3; LDS_GET(e0, v0, v1, v2, v3)
        bf_last(v0, v1, v2, v3);
        *(uint4*)(spec_o + e0) = make_uint4(pack2(v0.x, v0.y), pack2(v1.x, v1.y), pack2(v2.x, v2.y), pack2(v3.x, v3.y));
        LDS_PUT(e0, unpk(uz.x), unpk(uz.y), unpk(uz.z), unpk(uz.w))
      }
    }
    __syncthreads();
    fft_fwd(buf);
#pragma unroll 2
    for (int q = 0; q < 8; ++q) {
      const int e0 = E0(q);
      const uint4 us = *(const uint4*)(spec_e + e0);
      float2 v0, v1, v2, v3; LDS_GET(e0, v0, v1, v2, v3)
      bf_last(v0, v1, v2, v3);
      v0 = cmulf(v0, unpk(us.x)); v1 = cmulf(v1, unpk(us.y)); v2 = cmulf(v2, unpk(us.z)); v3 = cmulf(v3, unpk(us.w));
      bi_first(v0, v1, v2, v3);
      LDS_PUT(e0, v0, v1, v2, v3)
    }
    __syncthreads();
    fft_inv(buf);
#pragma unroll 2
    for (int q = 0; q < 8; ++q) {
      const int e0 = E0(q);
      const uint4 uz = *(const uint4*)(zs + e0);
      float2 v0, v1, v2, v3; LDS_GET(e0, v0, v1, v2, v3)
      *(uint4*)(spec_e + e0) = make_uint4(pack2(v0.x, v0.y), pack2(v1.x, v1.y), pack2(v2.x, v2.y), pack2(v3.x, v3.y));
      const float2 z[4] = {unpk(uz.x), unpk(uz.y), unpk(uz.z), unpk(uz.w)};
      float2 w[4];
#pragma unroll
      for (int k = 0; k < 4; ++k) { float c, sn; twid(e0 + k, c, sn); w[k] = make_float2(z[k].x * c - z[k].y * sn, z[k].x * sn + z[k].y * c); }
      LDS_PUT(e0, w[0], w[1], w[2], w[3])
    }
    __syncthreads();
    fft_fwd(buf);
#pragma unroll 2
    for (int q = 0; q < 8; ++q) {
      const int e0 = E0(q);
      const uint4 us = *(const uint4*)(spec_o + e0);
      float2 v0, v1, v2, v3; LDS_GET(e0, v0, v1, v2, v3)
      bf_last(v0, v1, v2, v3);
      v0 = cmulf(v0, unpk(us.x)); v1 = cmulf(v1, unpk(us.y)); v2 = cmulf(v2, unpk(us.z)); v3 = cmulf(v3, unpk(us.w));
      bi_first(v0, v1, v2, v3);
      LDS_PUT(e0, v0, v1, v2, v3)
    }
    __syncthreads();
    fft_inv(buf);
    const int xc = 512 * (o + 1) + ch;
    const u16* x0r = uT + (size_t)(0 * 1536 + xc) * S;
    const u16* x1r = uT + (size_t)(1 * 1536 + xc) * S;
    const float xw0 = p.cw[0 * 1536 + xc], xw1 = p.cw[1 * 1536 + xc], xw2 = p.cw[2 * 1536 + xc], xbv = p.cb[xc];
    const float sc = rnorm * (1.0f / 32768.0f);
    u16* hg0 = hgT + (size_t)(0 * 512 + ch) * S;
    u16* hg1 = hgT + (size_t)(1 * 512 + ch) * S;
#pragma unroll 2
    for (int q = 0; q < 8; ++q) {
      const int e0 = E0(q);
      const uint4 ue = *(const uint4*)(spec_e + e0);
      const uint4 uz = *(const uint4*)(zs + e0);
      float g0[4], g1[4]; conv3x4(x0r, e0, xw0, xw1, xw2, xbv, g0); conv3x4(x1r, e0, xw0, xw1, xw2, xbv, g1);
      float h0[4] = {1.f, 1.f, 1.f, 1.f}, h1[4] = {1.f, 1.f, 1.f, 1.f};
      if (o == 1) { bf4(*(const uint2*)(hg0 + e0), h0); bf4(*(const uint2*)(hg1 + e0), h1); }
      float2 yo[4]; LDS_GET(e0, yo[0], yo[1], yo[2], yo[3])
      const float2 ye[4] = {unpk(ue.x), unpk(ue.y), unpk(ue.z), unpk(ue.w)};
      const float2 z[4] = {unpk(uz.x), unpk(uz.y), unpk(uz.z), unpk(uz.w)};
      float r0[4], r1[4];
#pragma unroll
      for (int k = 0; k < 4; ++k) {
        float c, sn; twid(e0 + k, c, sn); sn = -sn;
        const float y0 = (ye[k].x + yo[k].x * c - yo[k].y * sn) * sc;
        const float y1 = (ye[k].y + yo[k].x * sn + yo[k].y * c) * sc;
        r0[k] = g0[k] * (y0 + z[k].x * dsk) * h0[k]; r1[k] = g1[k] * (y1 + z[k].y * dsk) * h1[k];
      }
      if (o == 0) *(uint4*)(zs + e0) = make_uint4(pack2(r0[0], r1[0]), pack2(r0[1], r1[1]), pack2(r0[2], r1[2]), pack2(r0[3], r1[3]));
      else {
        *(uint2*)(hg0 + e0) = make_uint2(pack2(r0[0], r0[1]), pack2(r0[2], r0[3]));
        *(uint2*)(hg1 + e0) = make_uint2(pack2(r1[0], r1[1]), pack2(r1[2], r1[3]));
      }
    }
    __syncthreads();
  }
#undef E0
#undef LDS_GET
#undef LDS_PUT
  {
    float* sm = (float*)smem;
    float* hf = sm;
    float* hb = sm + 256;
    float* zc = sm + 512;
    const float* utc = (const float*)(p.ws + OFF_UTC);
    const float* hgc = (const float*)(p.ws + OFF_HGTC);
    const float* flc = (const float*)(p.ws + OFF_FILTTC);
    const int b = t >> 8, tt = t & 255;
    const float cw0 = p.cw[0 * 1536 + ch], cw1 = p.cw[1 * 1536 + ch], cw2 = p.cw[2 * 1536 + ch], cbv = p.cb[ch];
    __syncthreads();
    zc[b * 256 + tt] = conv3_f(utc + (size_t)(b * 1536 + ch) * NC, tt, NC, cw0, cw1, cw2, cbv);
    for (int o = 0; o < 2; ++o) {
      float tap = flc[(size_t)(o * 1024 + b * 512 + ch) * NC + tt];
      float sq = (b == 1 && tt == 0) ? 0.f : tap * tap;
      const float rnorm = rsqrtf(block_sum(sq, red) + EPSF);
      if (b == 0) sm[255 + tt] = tap; else if (tt > 0) sm[255 - tt] = tap;
      __syncthreads();
      float a = 0.f;
      {
        const float* tp = sm + 255 + tt;
        const float4* z4 = (const float4*)(zc + b * 256);
#pragma unroll 4
        for (int s4 = 0; s4 < 64; ++s4) {
          const float4 zv = z4[s4];
          a += tp[-(4 * s4)] * zv.x; a += tp[-(4 * s4 + 1)] * zv.y; a += tp[-(4 * s4 + 2)] * zv.z; a += tp[-(4 * s4 + 3)] * zv.w;
        }
      }
      const int xc = 512 * (o + 1) + ch;
      const float g = conv3_f(utc + (size_t)(b * 1536 + xc) * NC, tt, NC, p.cw[0 * 1536 + xc], p.cw[1 * 1536 + xc], p.cw[2 * 1536 + xc], p.cb[xc]);
      const float res = g * (a * rnorm + zc[b * 256 + tt] * p.skip[o * 512 + ch]);
      __syncthreads();
      if (o == 0) zc[b * 256 + tt] = res;
      else {
        const float hg = hgc[(size_t)(b * 512 + ch) * NC + tt];
        ((u16*)(p.ws + OFF_Y))[(size_t)(MLAT + b * NC + tt) * 1024 + 512 + ch] = f2bf(res * hg);
      }
      __syncthreads();
    }
  }
}

DI void phase3(const Params& p, unsigned char* smem, bool do_h, bool do_a) {
  const int w = threadIdx.x >> 6, lane = threadIdx.x & 63, r = lane & 31;
#pragma nounroll
  for (int it = blockIdx.x; it < (do_h ? 512 : 0); it += gridDim.x) hyena_job(p, it, smem);
#pragma nounroll
  for (int it = blockIdx.x; it < (do_a ? 1024 + 16 : 0); it += gridDim.x) {
    __syncthreads();
    const bool isc = it >= 1024;
    const int u = isc ? it - 1024 : it;
    const int b = isc ? (u >> 3) : (u >> 9), kvh = isc ? ((u >> 2) & 1) : ((u >> 8) & 1), qt = isc ? (u & 3) : (u & 255);
    const int head = kvh * 4 + (w >> 1); const int q0 = qt * 64 + (w & 1) * 32;
    const u16* Qw = isc ? (const u16*)(p.ws + OFF_QC) + ((size_t)(b * 8 + head) * NC + q0) * 64
                        : (const u16*)(p.ws + OFF_Q) + ((size_t)(b * 8 + head) * S + q0) * 64;
    u16* yrow = (u16*)(p.ws + OFF_Y) + (size_t)((isc ? MLAT + b * NC : b * S) + q0 + r) * 1024 + head * 64;
    attn_unit<0>(Qw, (const u16*)(p.ws + OFF_K) + (size_t)(b * 2 + kvh) * KTOT * 64,
                 (const u16*)(p.ws + OFF_VT) + (size_t)(b * 2 + kvh) * 64 * KTOT,
                 isc ? NC / 64 : KTOT / 64, 0, 0, q0, 0, 0.f, nullptr, yrow, smem);
  }
}

DI void phase4(const Params& p, unsigned char* smem) {
  u16* tile = (u16*)smem;
  const u16* src = (const u16*)(p.ws + OFF_HGT);
  u16* y = (u16*)(p.ws + OFF_Y);
  const int t = threadIdx.x;
  if (blockIdx.x < 8) { uint4 q0_, q1_, q2_, q3_, q4_, q5_, q6_, q7_; gemm_tile<2>(p, (const u16*)(p.ws + OFF_Y), (const u16*)(p.ws + OFF_WOUTT), MLAT + (blockIdx.x >> 2) * 256, (blockIdx.x & 3) * 256, smem, q0_, q1_, q2_, q3_, q4_, q5_, q6_, q7_, false, 0, 0, false); return; }
  for (int it = blockIdx.x - 8; it < 4096; it += gridDim.x - 8) {
    const int b = it >> 11, ct = (it >> 8) & 7, st = it & 255;
    __syncthreads();
#pragma unroll
    for (int i = 0; i < 8; ++i) { int e = t + 512 * i; int c = e >> 6, s = e & 63; tile[c * 66 + s] = src[(size_t)(b * 512 + ct * 64 + c) * S + st * 64 + s]; }
    __syncthreads();
#pragma unroll
    for (int i = 0; i < 8; ++i) { int e = t + 512 * i; int s = e >> 6, c = e & 63; y[(size_t)(b * S + st * 64 + s) * 1024 + 512 + ct * 64 + c] = tile[c * 66 + s]; }
  }
}

DI void phase8(const Params& p, unsigned char* smem) {
  const int w = threadIdx.x >> 6, lane = threadIdx.x & 63, r = lane & 31;
  float* rpbs = (float*)(smem + 73728);
  for (int it = blockIdx.x; it < 2048; it += gridDim.x) {
    __syncthreads();
    if (it < 1024) {
      const int u = it; const int b = u >> 9, kvh = (u >> 8) & 1, qt = u & 255;
      const int head = kvh * 4 + (w >> 1); const int q0 = qt * 64 + (w & 1) * 32;
      int lo = qt * 64 - 128; if (lo < 0) lo = 0;
      int hi = qt * 64 + 192; if (hi > S) hi = S;
      attn_unit<1>((const u16*)(p.ws + OFF_QW) + ((size_t)(b * 8 + head) * S + q0) * 64,
                   (const u16*)(p.ws + OFF_KW) + (size_t)(b * 2 + kvh) * KTOT * 64,
                   (const u16*)(p.ws + OFF_VWT) + (size_t)(b * 2 + kvh) * 64 * KTOT,
                   NC / 64, NC + lo, (hi - lo) / 64, q0, 0, p.sink[head] * LOG2E, nullptr,
                   (u16*)(p.ws + OFF_Y) + (size_t)(b * S + q0 + r) * 1024 + head * 64, smem);
    } else {
      const int u = it - 1024; const int b = u >> 9, head = (u >> 6) & 7, rt = u & 63;
      const int R0 = rt * 4;
      for (int e = threadIdx.x; e < 465; e += 512) rpbs[e] = p.rpb[head * 465 + e] * LOG2E;
      int rlo = R0 - 4; rlo = rlo < 0 ? 0 : (rlo > 248 ? 248 : rlo);
      int rhi = R0 + 3 - 4; rhi = rhi < 0 ? 0 : (rhi > 248 ? 248 : rhi); rhi += 7;
      const int qr = R0 + (w >> 1); const int q0 = qr * 64 + (w & 1) * 32;
      attn_unit<2>((const u16*)(p.ws + OFF_QN) + ((size_t)(b * 8 + head) * S + q0) * 64,
                   (const u16*)(p.ws + OFF_KN) + (size_t)(b * 8 + head) * KTOT * 64,
                   (const u16*)(p.ws + OFF_VNT) + (size_t)(b * 8 + head) * 64 * KTOT,
                   NC / 64, NC + rlo * 64, rhi - rlo + 1, q0, qr, 0.f, rpbs,
                   (u16*)(p.ws + OFF_Y) + (size_t)(b * S + q0 + r) * 1024 + 512 + head * 64, smem);
    }
  }
}

#define XB_TMO      128
#define XB_XCNT(j)  (256  + 64 * (j))
#define XB_XSUB(j)  (1280 + 64 * (j))
#define XB_XGEN(j)  (2304 + 64 * (j))
#define XB_TOP      3328
#define XB_TOPGEN   3392
#define XCD_BAR_WORDS 3456
#define XB_SPIN_CAP (1u << 18)
#define LAS __attribute__((address_space(3)))

__device__ __forceinline__ unsigned xb_ld(unsigned* p)              { return __hip_atomic_load(p, __ATOMIC_RELAXED, __HIP_MEMORY_SCOPE_AGENT); }
__device__ __forceinline__ unsigned xb_add(unsigned* p, unsigned v) { return __hip_atomic_fetch_add(p, v, __ATOMIC_RELAXED, __HIP_MEMORY_SCOPE_AGENT); }
__device__ __forceinline__ unsigned xb_xcc_id() { return (unsigned)__builtin_amdgcn_s_getreg((3 << 11) | 20) & 0xFu; }
#define XB_SPIN(cond, bar) do { unsigned _sp = 0; while (cond) { __builtin_amdgcn_s_sleep(1); \
    if ((++_sp & 255u) == 0u) { if (xb_ld(&(bar)[XB_TMO])) break; if (_sp > XB_SPIN_CAP) { atomicAdd(&(bar)[XB_TMO], 1u); break; } } } } while (0)

struct XcdBarrier {
    unsigned* bar; unsigned x;
    volatile LAS unsigned* st;
};

__device__ __forceinline__ XcdBarrier xcd_barrier_post(unsigned* bar, volatile LAS unsigned* st) {
    XcdBarrier b; b.bar = bar; b.x = xb_xcc_id(); b.st = st;
    if (threadIdx.x == 0) (void)xb_add(&bar[XB_XCNT(b.x)], 1u);
    return b;
}
__device__ __forceinline__ void xcd_barrier_complete(unsigned* bar, unsigned x, unsigned& nloc, unsigned& nx) {
    const unsigned G = gridDim.x * gridDim.y * gridDim.z;
    unsigned sum, cnt, mine, sp = 0u;
    for (;;) {
        sum = 0u; cnt = 0u; mine = 0u;
#pragma unroll
        for (unsigned j = 0; j < 16; ++j) { const unsigned c = xb_ld(&bar[XB_XCNT(j)]); sum += c; cnt += (c > 0u) ? 1u : 0u; mine = (j == x) ? c : mine; }
        if (sum == G) break;
        __builtin_amdgcn_s_sleep(1);
        if ((++sp & 255u) == 0u) { if (xb_ld(&bar[XB_TMO])) break; if (sp > XB_SPIN_CAP) { atomicAdd(&bar[XB_TMO], 1u); break; } }
    }
    nloc = mine > 0u ? mine : 1u; nx = cnt > 0u ? cnt : 1u;
}

__device__ __forceinline__ void xcd_barrier(const XcdBarrier& b) {
    asm volatile("s_waitcnt vmcnt(0)" ::: "memory");
    __syncthreads();
    if (threadIdx.x == 0) {
        unsigned* bar = b.bar;
        __builtin_amdgcn_s_waitcnt(0);
        unsigned nloc = b.st[0], nx = b.st[1];
        if (nloc == 0u) { xcd_barrier_complete(bar, b.x, nloc, nx); b.st[0] = nloc; b.st[1] = nx; }
        const unsigned old = xb_add(&bar[XB_XSUB(b.x)], 1u);
        const unsigned gen = old / nloc;
        if (old + 1u == (gen + 1u) * nloc) {
            __builtin_amdgcn_fence(__ATOMIC_RELEASE, "agent");
            asm volatile("s_waitcnt vmcnt(0)" ::: "memory");
            const unsigned og = xb_add(&bar[XB_TOP], 1u);
            const unsigned tg = og / nx;
            if (og + 1u == (tg + 1u) * nx) xb_add(&bar[XB_TOPGEN], 1u);
            else XB_SPIN(xb_ld(&bar[XB_TOPGEN]) == tg, bar);
            __builtin_amdgcn_fence(__ATOMIC_ACQUIRE, "agent");
            xb_add(&bar[XB_XGEN(b.x)], 1u);
            asm volatile("s_waitcnt vmcnt(0)" ::: "memory");
        } else {
            XB_SPIN(xb_ld(&bar[XB_XGEN(b.x)]) == gen, bar);
            __builtin_amdgcn_fence(__ATOMIC_ACQUIRE, "agent");
            asm volatile("s_waitcnt vmcnt(0)" ::: "memory");
        }
    }
    __syncthreads();
}


__global__ void __launch_bounds__(NTHR) hybrid_fwd(Params p) {
  extern __shared__ __attribute__((aligned(16))) unsigned char smem[];
  cg::grid_group grid = cg::this_grid();
  const u16* h = (const u16*)(p.ws + OFF_H);
  const u16* y = (const u16*)(p.ws + OFF_Y);
  const u16* winT = (const u16*)(p.ws + OFF_WINT);
  const u16* woutT = (const u16*)(p.ws + OFF_WOUTT);
#ifndef PROBE
#define PROBE 0
#endif
  volatile LAS unsigned* xst = (volatile LAS unsigned*)(smem + 147456);
  if (threadIdx.x == 0) { xst[0] = 0u; xst[1] = 0u; xst[2] = 0u; xst[3] = 0u; }
  __syncthreads();
  const XcdBarrier xb = xcd_barrier_post((unsigned*)(p.ws + OFF_BAR), xst);
#define STEP(stmt) if (PH(__LINE__)) { stmt; xcd_barrier(xb); }
  if (p.phase_hi < 0) grid.sync();
  STEP(phase0(p, smem))
  STEP(phase1(p, smem))
#if PROBE == 8
  for (int i = 0; i < 10; ++i) grid.sync();
#endif
  STEP(gemm_phase<0>(p, h, winT, MALL / 256, INW / 256, 4, smem))
#if PROBE == 1
  STEP(phase3(p, smem, false, true))
  STEP(gemm_phase<0>(p, h, winT, MALL / 256, INW / 256, 4, smem))
#endif
#if PROBE == 7
  STEP(phase3(p, smem, true, false))
  STEP(phase1(p, smem))
  STEP(gemm_phase<0>(p, h, winT, MALL / 256, INW / 256, 4, smem))
#endif
  STEP(phase3(p, smem, true, true))
#if PROBE == 6
  STEP(phase1(p, smem))
#endif
#if PROBE == 2
  STEP(phase1(p, smem))
  STEP(gemm_phase<0>(p, h, winT, MALL / 256, INW / 256, 4, smem))
  STEP(phase3(p, smem, true, true))
#endif
  STEP(phase4(p, smem))
  STEP(gemm_phase<2>(p, y, woutT, MLAT / 256, 4, 8, smem))
#if PROBE == 4
  STEP(gemm_phase<2>(p, y, woutT, MLAT / 256, 4, 8, smem))
#endif
  STEP(for (int it = blockIdx.x; it < 2080; it += gridDim.x) modnorm_rows(p, 1, it))
  STEP(gemm_phase<1>(p, h, winT + (size_t)INW * 1024, MALL / 256, INW / 256, 4, smem))
#if PROBE == 3
  STEP(gemm_phase<1>(p, h, winT + (size_t)INW * 1024, MALL / 256, INW / 256, 4, smem))
#endif
#if PROBE == 5
  STEP(phase8(p, smem))
  STEP(gemm_phase<1>(p, h, winT + (size_t)INW * 1024, MALL / 256, INW / 256, 4, smem))
#endif
  STEP(phase8(p, smem))
  gemm_phase<3>(p, y, woutT + (size_t)1024 * 1024, MLAT / 256, 4, 8, smem);
}

extern "C" void kernel_launch(void* const* d_in, const int* in_sizes, int n_in, void* d_out, int out_size, void* d_ws, size_t ws_size, hipStream_t stream) {
  static int grid_blocks = 0;
  if (grid_blocks == 0) {
    if (n_in != 26 || ws_size < WS_NEED) { fprintf(stderr, "kernel_launch: unexpected n_in %d or ws_size %zu (need %zu)\n", n_in, ws_size, (size_t)WS_NEED); grid_blocks = -1; return; }
    int dev = 0, cus = 0, per_cu = 0;
    hipGetDevice(&dev);
    hipDeviceGetAttribute(&cus, hipDeviceAttributeMultiprocessorCount, dev);
    if (hipFuncSetAttribute((const void*)hybrid_fwd, hipFuncAttributeMaxDynamicSharedMemorySize, LDS_BYTES) != hipSuccess) { fprintf(stderr, "kernel_launch: hipFuncSetAttribute failed\n"); grid_blocks = -1; return; }
    if (hipOccupancyMaxActiveBlocksPerMultiprocessor(&per_cu, (const void*)hybrid_fwd, NTHR, LDS_BYTES) != hipSuccess || per_cu < 1) { fprintf(stderr, "kernel_launch: occupancy query failed (%d)\n", per_cu); grid_blocks = -1; return; }
    int g = cus * per_cu; if (g > 256) g = 256;
    grid_blocks = g;
  }
  if (grid_blocks < 0) return;
  Params p{};
  const float* const* in = (const float* const*)d_in;
  p.x = in[0]; p.c = in[1]; p.ctx = in[2]; p.c_ctx = in[3]; p.norm_g = in[4]; p.w_ada = in[5]; p.b_ada = in[6]; p.w_in = in[7]; p.w_out = in[8];
  p.gq = in[9]; p.gk = in[10]; p.cw = in[11]; p.cb = in[12]; p.w1 = in[13]; p.b1 = in[14]; p.w2 = in[15]; p.b2 = in[16]; p.fr = in[17]; p.w3 = in[18]; p.skip = in[19];
  p.wqn = in[20]; p.wkn = in[21]; p.sink = in[22]; p.nqn = in[23]; p.nkn = in[24]; p.rpb = in[25];
  p.out = (float*)d_out; p.ws = (unsigned char*)d_ws;
  p.phase_lo = 0; p.phase_hi = 10;
  if (hipMemsetAsync((unsigned char*)d_ws + OFF_BAR, 0, XCD_BAR_WORDS * sizeof(unsigned), stream) != hipSuccess) { fprintf(stderr, "kernel_launch: memset of the barrier words failed\n"); return; }
  void* args[] = {&p};
  hipError_t e = hipLaunchCooperativeKernel((const void*)hybrid_fwd, dim3(grid_blocks), dim3(NTHR), args, LDS_BYTES, stream);
  if (e != hipSuccess) fprintf(stderr, "kernel_launch: cooperative launch failed: %s (grid %d)\n", hipGetErrorString(e), grid_blocks);
}
```
